# Optimizing an MI355X kernel written in HIP

```python
import math
import jax, jax.numpy as jnp
from jax import lax
import numpy as np

D_MODEL = 1024
BATCH = 4
SEQ = 8192
DEPTH = 1
DEC_BATCH = 16
DEC_SEQ = 16
PAST_LEN = 2048

CHUNK = 64
D_MIX = D_MODEL
D_ATTN = D_MIX // 2
D_SSM = D_MIX - D_ATTN
HEAD_DIM = 64
N_HEADS = D_ATTN // HEAD_DIM
N_KV_HEADS = 2
Q_PER_KV = N_HEADS // N_KV_HEADS
KV_W = N_KV_HEADS * HEAD_DIM
WINDOW = 128
N_WIN_CHUNKS = WINDOW // CHUNK
ROPE_THETA = 10000.0
SSM_GROUP = 16
N_SSM_GROUPS = D_SSM // SSM_GROUP
SSM_STATE = 64
D_FF = ((8 * D_MODEL // 3 + 127) // 128) * 128
CONV_W = 3
EPS = 1e-6
D_IN = D_ATTN + 2 * KV_W + D_SSM

kernel_name = "hymba_swa_s5_convffn_stream_step"


def rmsnorm(x, g):
    xf = x.astype(jnp.float32)
    y = xf * lax.rsqrt(jnp.mean(xf * xf, axis=-1, keepdims=True) + EPS) * g.astype(jnp.float32)
    return y.astype(x.dtype)


def rope(x, pos):
    half = HEAD_DIM // 2
    inv = ROPE_THETA ** (-jnp.arange(half, dtype=jnp.float32) / half)
    ang = pos.astype(jnp.float32)[:, None] * inv[None, :]
    cos = jnp.cos(ang)[:, None, :]
    sin = jnp.sin(ang)[:, None, :]
    xf = x.astype(jnp.float32)
    x1, x2 = xf[..., :half], xf[..., half:]
    return jnp.concatenate([x1 * cos - x2 * sin, x2 * cos + x1 * sin], axis=-1).astype(x.dtype)


def sink_softmax(s, mask, sink):
    s = jnp.where(mask, s, -jnp.inf)
    m = jnp.maximum(jnp.max(s, axis=-1, keepdims=True), sink)
    e = jnp.exp(s - m)
    return e / (jnp.sum(e, axis=-1, keepdims=True) + jnp.exp(sink - m))


def window_attention_prompt(q, k, v, sinks):
    B, L = q.shape[:2]
    nb = L // CHUNK
    qb = q.reshape(B, nb, CHUNK, N_KV_HEADS, Q_PER_KV, HEAD_DIM)
    pad = N_WIN_CHUNKS * CHUNK

    def band(t):
        tp = jnp.pad(t, ((0, 0), (pad, 0), (0, 0), (0, 0)))
        tp = tp.reshape(B, nb + N_WIN_CHUNKS, CHUNK, N_KV_HEADS, HEAD_DIM)
        return jnp.concatenate([tp[:, j:j + nb] for j in range(N_WIN_CHUNKS + 1)], axis=2)

    kb, vb = band(k), band(v)
    kpos = (jnp.arange(nb)[:, None] - N_WIN_CHUNKS) * CHUNK + jnp.arange((N_WIN_CHUNKS + 1) * CHUNK)[None, :]
    mask = (kpos >= 0)[:, None, None, None, :]
    s = jnp.einsum('bnqgrd,bnkgd->bngrqk', qb, kb).astype(jnp.float32) * (HEAD_DIM ** -0.5)
    sink = sinks.astype(jnp.float32).reshape(N_KV_HEADS, Q_PER_KV)[:, :, None, None]
    p = sink_softmax(s, mask, sink)
    o = jnp.einsum('bngrqk,bnkgd->bnqgrd', p.astype(v.dtype), vb)
    return o.reshape(B, L, D_ATTN)


def window_attention_step(q, k_all, v_all, qpos, kpos, sinks):
    B, S = q.shape[:2]
    qg = q.reshape(B, S, N_KV_HEADS, Q_PER_KV, HEAD_DIM)
    s = jnp.einsum('bqgrd,bkgd->bgrqk', qg, k_all).astype(jnp.float32) * (HEAD_DIM ** -0.5)
    qc = qpos // CHUNK
    kc = kpos // CHUNK
    mask = (kc[None, :] <= qc[:, None]) & (kc[None, :] >= qc[:, None] - N_WIN_CHUNKS) & (kpos[None, :] >= 0)
    sink = sinks.astype(jnp.float32).reshape(N_KV_HEADS, Q_PER_KV)[:, :, None, None]
    p = sink_softmax(s, mask, sink)
    o = jnp.einsum('bgrqk,bkgd->bqgrd', p.astype(v_all.dtype), v_all)
    return o.reshape(B, S, D_ATTN)


def s5_glu(u, h0, A_re, A_im, log_dt, B_re, B_im, C_re, C_im, Dskip, w_glu):
    Bsz, L = u.shape[:2]
    f32 = jnp.float32
    uf = u.astype(f32).reshape(Bsz, L, N_SSM_GROUPS, SSM_GROUP)
    A = lax.complex(A_re.astype(f32), A_im.astype(f32))
    dtA = jnp.exp(log_dt.astype(f32))[:, None] * A
    A_bar = jnp.exp(dtA)
    B_bar = ((A_bar - 1.0) / A)[:, :, None] * lax.complex(B_re.astype(f32), B_im.astype(f32))
    bu = jnp.einsum('blgc,gpc->blgp', uf.astype(jnp.complex64), B_bar)
    if h0 is not None:
        h_prev = lax.complex(h0[0].astype(f32), h0[1].astype(f32))
        bu = bu.at[:, 0].add(A_bar[None] * h_prev)
    a = jnp.broadcast_to(A_bar, (1, L, N_SSM_GROUPS, SSM_STATE))

    def combine(e1, e2):
        a1, b1 = e1
        a2, b2 = e2
        return a1 * a2, a2 * b1 + b2

    _, h = lax.associative_scan(combine, (a, bu), axis=1)
    C = lax.complex(C_re.astype(f32), C_im.astype(f32))
    y = jnp.einsum('gcp,blgp->blgc', C, h).real + Dskip.astype(f32)[None, None] * uf
    z = jax.nn.gelu(y.reshape(Bsz, L, D_SSM))
    out = z * jax.nn.sigmoid(z @ w_glu.astype(f32))
    h_last = h[:, -1]
    return out.astype(u.dtype), h_last.real, h_last.imag


def conv_ffn(x, prev, w_up, conv_w, conv_b, w_down):
    B, L = x.shape[:2]
    up = x @ w_up
    if prev is None:
        prev = jnp.zeros((B, CONV_W - 1, up.shape[-1]), up.dtype)
    up_p = jnp.concatenate([prev.astype(up.dtype), up], axis=1)
    c = sum(up_p[:, j:j + L] * conv_w[j] for j in range(CONV_W)) + conv_b
    gate, val = jnp.split(c, 2, axis=-1)
    return (jax.nn.silu(gate) * val) @ w_down, up_p[:, -(CONV_W - 1):]


def layer(x, start, lw, kv_prev, ssm_prev, conv_prev):
    B, L = x.shape[:2]
    pos = start + jnp.arange(L)
    h = rmsnorm(x, lw['norm1'])
    proj = h @ lw['w_in']
    q, k, v, u = jnp.split(proj, [D_ATTN, D_ATTN + KV_W, D_ATTN + 2 * KV_W], axis=-1)
    q = rope(q.reshape(B, L, N_HEADS, HEAD_DIM), pos)
    k = rope(k.reshape(B, L, N_KV_HEADS, HEAD_DIM), pos)
    v = v.reshape(B, L, N_KV_HEADS, HEAD_DIM)
    if kv_prev is None:
        a = window_attention_prompt(q, k, v, lw['sinks'])
        new_k, new_v = k[:, -WINDOW:], v[:, -WINDOW:]
    else:
        ck, cv = kv_prev
        n_buf = ck.shape[1]
        k_all = jnp.concatenate([ck.astype(k.dtype), k], axis=1)
        v_all = jnp.concatenate([cv.astype(v.dtype), v], axis=1)
        kpos = start - n_buf + jnp.arange(n_buf + L)
        a = window_attention_step(q, k_all, v_all, pos, kpos, lw['sinks'])
        new_k, new_v = k_all[:, -n_buf:], v_all[:, -n_buf:]
    s, h_re, h_im = s5_glu(u, ssm_prev, lw['A_re'], lw['A_im'], lw['log_dt'], lw['B_re'], lw['B_im'],
                           lw['C_re'], lw['C_im'], lw['D'], lw['w_glu'])
    merged = jnp.concatenate([rmsnorm(a, lw['onorm_a']), rmsnorm(s, lw['onorm_s'])], axis=-1)
    x = x + merged @ lw['w_out']
    f, new_conv = conv_ffn(rmsnorm(x, lw['norm2']), conv_prev, lw['w_up'], lw['conv_w'], lw['conv_b'], lw['w_down'])
    x = x + f
    return x, new_k, new_v, h_re, h_im, new_conv


def setup_inputs(seed: int = 0) -> dict:
    key = jax.random.key(seed)
    ks = jax.random.split(key, 32)
    f32 = jnp.float32
    n = lambda k, shape, scale: jax.random.normal(k, shape, f32) * scale
    kv_rows = min(WINDOW, PAST_LEN)
    log_dt = jax.random.uniform(ks[10], (DEPTH, N_SSM_GROUPS), f32, math.log(1e-3), math.log(1e-1))
    a_im = jnp.broadcast_to(math.pi * jnp.arange(SSM_STATE, dtype=f32), (DEPTH, N_SSM_GROUPS, SSM_STATE))
    return {
        "x_prompt": n(ks[0], (BATCH, SEQ, D_MODEL), 1.0),
        "x_sample": n(ks[1], (DEC_BATCH, DEC_SEQ, D_MODEL), 1.0),
        "cache_k": n(ks[2], (DEPTH, DEC_BATCH, kv_rows, N_KV_HEADS, HEAD_DIM), 1.0),
        "cache_v": n(ks[3], (DEPTH, DEC_BATCH, kv_rows, N_KV_HEADS, HEAD_DIM), 1.0),
        "state_ssm_re": n(ks[4], (DEPTH, DEC_BATCH, N_SSM_GROUPS, SSM_STATE), 0.5),
        "state_ssm_im": n(ks[5], (DEPTH, DEC_BATCH, N_SSM_GROUPS, SSM_STATE), 0.5),
        "state_conv": n(ks[6], (DEPTH, DEC_BATCH, CONV_W - 1, 2 * D_FF), 1.0),
        "norm1_g": 1.0 + n(ks[7], (DEPTH, D_MODEL), 0.02),
        "w_in": n(ks[8], (DEPTH, D_MODEL, D_IN), D_MODEL ** -0.5),
        "attn_sinks": n(ks[9], (DEPTH, N_HEADS), 0.5),
        "ssm_A_re": -0.5 + n(ks[11], (DEPTH, N_SSM_GROUPS, SSM_STATE), 0.01),
        "ssm_A_im": a_im + n(ks[12], (DEPTH, N_SSM_GROUPS, SSM_STATE), 0.01),
        "ssm_log_dt": log_dt,
        "ssm_B_re": n(ks[13], (DEPTH, N_SSM_GROUPS, SSM_STATE, SSM_GROUP), (2 * SSM_GROUP) ** -0.5),
        "ssm_B_im": n(ks[14], (DEPTH, N_SSM_GROUPS, SSM_STATE, SSM_GROUP), (2 * SSM_GROUP) ** -0.5),
        "ssm_C_re": n(ks[15], (DEPTH, N_SSM_GROUPS, SSM_GROUP, SSM_STATE), (2 * SSM_STATE) ** -0.5),
        "ssm_C_im": n(ks[16], (DEPTH, N_SSM_GROUPS, SSM_GROUP, SSM_STATE), (2 * SSM_STATE) ** -0.5),
        "ssm_D": n(ks[17], (DEPTH, N_SSM_GROUPS, SSM_GROUP), 1.0),
        "w_glu": n(ks[18], (DEPTH, D_SSM, D_SSM), D_SSM ** -0.5),
        "onorm_attn_g": 1.0 + n(ks[19], (DEPTH, D_ATTN), 0.02),
        "onorm_ssm_g": 1.0 + n(ks[20], (DEPTH, D_SSM), 0.02),
        "w_out": n(ks[21], (DEPTH, D_MIX, D_MODEL), D_MIX ** -0.5),
        "norm2_g": 1.0 + n(ks[22], (DEPTH, D_MODEL), 0.02),
        "w_up": n(ks[23], (DEPTH, D_MODEL, 2 * D_FF), D_MODEL ** -0.5),
        "conv_w": n(ks[24], (DEPTH, CONV_W, 2 * D_FF), CONV_W ** -0.5),
        "conv_b": n(ks[25], (DEPTH, 2 * D_FF), 0.01),
        "w_down": n(ks[26], (DEPTH, D_FF, D_MODEL), D_FF ** -0.5),
        "final_g": 1.0 + n(ks[27], (D_MODEL,), 0.02),
    }


def reference(x_prompt, x_sample, cache_k, cache_v, state_ssm_re, state_ssm_im, state_conv,
              norm1_g, w_in, attn_sinks, ssm_A_re, ssm_A_im, ssm_log_dt, ssm_B_re, ssm_B_im,
              ssm_C_re, ssm_C_im, ssm_D, w_glu, onorm_attn_g, onorm_ssm_g, w_out, norm2_g,
              w_up, conv_w, conv_b, w_down, final_g):
    xp, xs = x_prompt, x_sample
    kp_l, vp_l, rp_l, ip_l, cp_l = [], [], [], [], []
    ks_l, vs_l, rs_l, is_l, cs_l = [], [], [], [], []
    for l in range(DEPTH):
        lw = dict(norm1=norm1_g[l], w_in=w_in[l], sinks=attn_sinks[l], A_re=ssm_A_re[l], A_im=ssm_A_im[l],
                  log_dt=ssm_log_dt[l], B_re=ssm_B_re[l], B_im=ssm_B_im[l], C_re=ssm_C_re[l],
                  C_im=ssm_C_im[l], D=ssm_D[l], w_glu=w_glu[l], onorm_a=onorm_attn_g[l],
                  onorm_s=onorm_ssm_g[l], w_out=w_out[l], norm2=norm2_g[l], w_up=w_up[l],
                  conv_w=conv_w[l], conv_b=conv_b[l], w_down=w_down[l])
        xp, kp, vp, rp, ip, cp = layer(xp, 0, lw, None, None, None)
        xs, ks_, vs_, rs_, is_, cs_ = layer(xs, PAST_LEN, lw, (cache_k[l], cache_v[l]),
                                            (state_ssm_re[l], state_ssm_im[l]), state_conv[l])
        kp_l.append(kp); vp_l.append(vp); rp_l.append(rp); ip_l.append(ip); cp_l.append(cp)
        ks_l.append(ks_); vs_l.append(vs_); rs_l.append(rs_); is_l.append(is_); cs_l.append(cs_)
    y_prompt = rmsnorm(xp, final_g)
    y_sample = rmsnorm(xs, final_g)
    return (y_prompt, y_sample,
            jnp.stack(kp_l), jnp.stack(vp_l), jnp.stack(rp_l), jnp.stack(ip_l), jnp.stack(cp_l),
            jnp.stack(ks_l), jnp.stack(vs_l), jnp.stack(rs_l), jnp.stack(is_l), jnp.stack(cs_l))
```

```cpp
#include <hip/hip_runtime.h>
#include <hip/hip_cooperative_groups.h>
#include <cstdio>
namespace cg = cooperative_groups;

#define LAS __attribute__((address_space(3)))
typedef unsigned short bf16_t;
typedef short bf16x8 __attribute__((ext_vector_type(8)));
typedef float f32x4 __attribute__((ext_vector_type(4)));
typedef unsigned u32x4 __attribute__((ext_vector_type(4)));
typedef unsigned u32x2 __attribute__((ext_vector_type(2)));

constexpr int DM = 1024, NPR = 32768, NSR = 256, MR = NPR + NSR, SEQ = 8192;
constexpr int DFF = 2816, DFF2 = 5632, NG = 32;
constexpr float EPS = 1e-6f;
constexpr int NTHR = 512;
constexpr int LDS_BYTES = 131072 + 16;

constexpr size_t al(size_t x) { return (x + 255) & ~(size_t)255; }
constexpr size_t WS_BAR = 0;
constexpr size_t WS_RSS_S = al((size_t)3456 * 4);
constexpr size_t WS_RSS_2 = WS_RSS_S + al((size_t)MR * 4);
constexpr size_t WS_RSS_3 = WS_RSS_2 + al((size_t)MR * 4);
constexpr size_t WS_CNT = WS_RSS_3 + al((size_t)MR * 4);
constexpr size_t WS_ROPE = WS_CNT + al((size_t)800 * 64);
constexpr size_t WS_LAM = WS_ROPE + al((size_t)8192 * 32 * 2 * 4);
constexpr size_t WS_BBAR = WS_LAM + al((size_t)32 * 64 * 4 * 4);
constexpr size_t WS_WIN = WS_BBAR + al((size_t)32 * 64 * 16 * 2 * 4);
constexpr size_t WS_WGLU = WS_WIN + al((size_t)1280 * 1024 * 2);
constexpr size_t WS_WOUT = WS_WGLU + al((size_t)512 * 512 * 2);
constexpr size_t WS_WUP = WS_WOUT + al((size_t)1024 * 1024 * 2);
constexpr size_t WS_WDOWN = WS_WUP + al((size_t)5632 * 1024 * 2);
constexpr size_t WS_WS = WS_WDOWN + al((size_t)1024 * 2816 * 2);
constexpr size_t WS_WY = WS_WS + al((size_t)32 * 256 * 256 * 2);
constexpr size_t WS_US = WS_WY + al((size_t)32 * 256 * 384 * 2);
constexpr size_t WS_X1B = WS_US + al((size_t)256 * 512 * 4);
constexpr size_t WS_R0 = WS_X1B + al((size_t)MR * 1024 * 2);
constexpr size_t WS_XN1 = WS_R0;
constexpr size_t WS_Q = WS_XN1 + al((size_t)MR * 1024 * 2);
constexpr size_t WS_K = WS_Q + al((size_t)MR * 512 * 2);
constexpr size_t WS_V = WS_K + al((size_t)MR * 128 * 2);
constexpr size_t WS_UH = WS_V + al((size_t)MR * 128 * 2);
constexpr size_t WS_SB = WS_UH + al((size_t)32 * 2048 * 384 * 2);
constexpr size_t WS_Z = WS_SB + al((size_t)32 * 2048 * 128 * 4);
constexpr size_t WS_MRG = WS_Z + al((size_t)MR * 512 * 2);
constexpr size_t WS_END1 = WS_MRG + al((size_t)MR * 1024 * 2);
constexpr size_t WS_H = WS_R0;
constexpr size_t WS_EB = WS_H + al((size_t)MR * 2816 * 2);
constexpr size_t WS_END2 = WS_EB + al((size_t)512 * 4 * 5632 * 4);
constexpr size_t WS_END = WS_END1 > WS_END2 ? WS_END1 : WS_END2;

constexpr size_t O_YP = 0, O_YS = 33554432, O_KP = O_YS + 262144, O_VP = O_KP + 65536, O_RP = O_VP + 65536, O_IP = O_RP + 8192,
                 O_CP = O_IP + 8192, O_KS = O_CP + 45056, O_VS = O_KS + 262144, O_RS = O_VS + 262144, O_IS = O_RS + 32768, O_CS = O_IS + 32768;

struct P {
    const float *x_prompt, *x_sample, *cache_k, *cache_v, *st_re, *st_im, *st_conv, *norm1_g, *w_in, *sinks, *A_re, *A_im, *log_dt, *B_re, *B_im,
        *C_re, *C_im, *Dskip, *w_glu, *on_a, *on_s, *w_out, *norm2_g, *w_up, *conv_w, *conv_b, *w_down, *final_g;
    float* out; unsigned char* ws; int ph_lo, ph_hi;
};

__device__ __forceinline__ unsigned pk2(float lo, float hi) { unsigned r; asm volatile("v_cvt_pk_bf16_f32 %0, %1, %2" : "=v"(r) : "v"(lo), "v"(hi)); return r; }
__device__ __forceinline__ float bf2f(bf16_t b) { return __uint_as_float(((unsigned)b) << 16); }
__device__ __forceinline__ float bflo(unsigned w) { return __uint_as_float(w << 16); }
__device__ __forceinline__ float bfhi(unsigned w) { return __uint_as_float(w & 0xffff0000u); }
__device__ __forceinline__ u32x2 pk4(f32x4 v) { u32x2 w; w.x = pk2(v[0], v[1]); w.y = pk2(v[2], v[3]); return w; }
__device__ __forceinline__ f32x4 ld4(const float* p) { return *(const f32x4*)p; }
__device__ __forceinline__ void st4(float* p, f32x4 v) { *(f32x4*)p = v; }
__device__ __forceinline__ float wsum(float v) { for (int o = 32; o >= 1; o >>= 1) v += __shfl_xor(v, o); return v; }
__device__ __forceinline__ float wmax(float v) { for (int o = 32; o >= 1; o >>= 1) v = fmaxf(v, __shfl_xor(v, o)); return v; }
__device__ __forceinline__ float gelu_tanh(float y) { const float u = 0.7978845608028654f * (y + 0.044715f * y * y * y); return y * __builtin_amdgcn_rcpf(1.0f + __expf(-2.0f * u)); }
__device__ __forceinline__ float sigmoidf(float x) { return __builtin_amdgcn_rcpf(1.0f + __expf(-x)); }

#define XB_TMO      128
#define XB_XCNT(j)  (256  + 64 * (j))
#define XB_XSUB(j)  (1280 + 64 * (j))
#define XB_XGEN(j)  (2304 + 64 * (j))
#define XB_TOP      3328
#define XB_TOPGEN   3392
#define XCD_BAR_WORDS 3456
#define XB_SPIN_CAP (1u << 18)
__device__ __forceinline__ unsigned xb_ld(unsigned* p)              { return __hip_atomic_load(p, __ATOMIC_RELAXED, __HIP_MEMORY_SCOPE_AGENT); }
__device__ __forceinline__ unsigned xb_add(unsigned* p, unsigned v) { return __hip_atomic_fetch_add(p, v, __ATOMIC_RELAXED, __HIP_MEMORY_SCOPE_AGENT); }
__device__ __forceinline__ unsigned xb_xcc_id() { return (unsigned)__builtin_amdgcn_s_getreg((3 << 11) | 20) & 0xFu; }
#define XB_SPIN(cond, bar) do { unsigned _sp = 0; while (cond) { __builtin_amdgcn_s_sleep(1); \
    if ((++_sp & 255u) == 0u) { if (xb_ld(&(bar)[XB_TMO])) break; if (_sp > XB_SPIN_CAP) { atomicAdd(&(bar)[XB_TMO], 1u); break; } } } } while (0)
struct XcdBarrier { unsigned* bar; unsigned x; volatile LAS unsigned* st; };
__device__ __forceinline__ XcdBarrier xcd_barrier_post(unsigned* bar, volatile LAS unsigned* st) {
    XcdBarrier b; b.bar = bar; b.x = xb_xcc_id(); b.st = st;
    if (threadIdx.x == 0) (void)xb_add(&bar[XB_XCNT(b.x)], 1u);
    return b;
}
__device__ __forceinline__ void xcd_barrier_complete(unsigned* bar, unsigned x, unsigned& nloc, unsigned& nx) {
    const unsigned G = gridDim.x * gridDim.y * gridDim.z;
    unsigned sum, cnt, mine, sp = 0u;
    for (;;) {
        sum = 0u; cnt = 0u; mine = 0u;
#pragma unroll
        for (unsigned j = 0; j < 16; ++j) { const unsigned c = xb_ld(&bar[XB_XCNT(j)]); sum += c; cnt += (c > 0u) ? 1u : 0u; mine = (j == x) ? c : mine; }
        if (sum == G) break;
        __builtin_amdgcn_s_sleep(1);
        if ((++sp & 255u) == 0u) { if (xb_ld(&bar[XB_TMO])) break; if (sp > XB_SPIN_CAP) { atomicAdd(&bar[XB_TMO], 1u); break; } }
    }
    nloc = mine > 0u ? mine : 1u; nx = cnt > 0u ? cnt : 1u;
}
__device__ __forceinline__ void xcd_barrier(const XcdBarrier& b) {
    asm volatile("s_waitcnt vmcnt(0)" ::: "memory");
    __syncthreads();
    if (threadIdx.x == 0) {
        unsigned* bar = b.bar;
        __builtin_amdgcn_s_waitcnt(0);
        unsigned nloc = b.st[0], nx = b.st[1];
        if (nloc == 0u) { xcd_barrier_complete(bar, b.x, nloc, nx); b.st[0] = nloc; b.st[1] = nx; }
        const unsigned old = xb_add(&bar[XB_XSUB(b.x)], 1u);
        const unsigned gen = old / nloc;
        if (old + 1u == (gen + 1u) * nloc) {
            __builtin_amdgcn_fence(__ATOMIC_RELEASE, "agent");
            asm volatile("s_waitcnt vmcnt(0)" ::: "memory");
            const unsigned og = xb_add(&bar[XB_TOP], 1u);
            const unsigned tg = og / nx;
            if (og + 1u == (tg + 1u) * nx) xb_add(&bar[XB_TOPGEN], 1u);
            else XB_SPIN(xb_ld(&bar[XB_TOPGEN]) == tg, bar);
            __builtin_amdgcn_fence(__ATOMIC_ACQUIRE, "agent");
            xb_add(&bar[XB_XGEN(b.x)], 1u);
            asm volatile("s_waitcnt vmcnt(0)" ::: "memory");
        } else {
            XB_SPIN(xb_ld(&bar[XB_XGEN(b.x)]) == gen, bar);
            __builtin_amdgcn_fence(__ATOMIC_ACQUIRE, "agent");
            asm volatile("s_waitcnt vmcnt(0)" ::: "memory");
        }
    }
    __syncthreads();
}

namespace pg8 {
constexpr int BM = 256, BK = 64, HALF = 128, HTB = HALF * BK * 2, NXCD = 8, WGM = 8;
__device__ __forceinline__ int lds_byte(int r, int c) { const int st = (r >> 4) * 2 + (c >> 5), rr = r & 15, cc = c & 31, ob = rr * 64 + cc * 2; return st * 1024 + (ob ^ (((ob >> 9) & 1) << 5)); }
__device__ __forceinline__ void stage_rc(int b, int& R, int& C) { const int st = b / 1024, sb = b % 1024, swz = sb ^ (((sb >> 9) & 1) << 5); R = (st >> 1) * 16 + swz / 64; C = (st & 1) * 32 + (swz % 64) / 2; }
struct Unit { int pm, pn; };
struct Gemm { const bf16_t* A; const bf16_t* Bt; int lda, ldb, K; };
struct StaticOrder {
    int nM, nN, nwg, G, c;
    __device__ __forceinline__ void init(int M, int N, int G_, int c_) { nM = M / BM; nN = N / BM; nwg = nM * nN; G = G_; c = c_; }
    __device__ __forceinline__ bool next(int i, Unit& u) const {
        const long L = (long)i * G + c; if (L >= nwg) return false;
        int wgid = (int)L; { const int q = nwg / NXCD, r = nwg % NXCD, xcd = wgid % NXCD, off = wgid / NXCD; wgid = (xcd < r ? xcd * (q + 1) : r * (q + 1) + (xcd - r) * q) + off; }
        const int nig = WGM * nN, gid = wgid / nig, fm = gid * WGM, gsz = (nM - fm) < WGM ? (nM - fm) : WGM;
        u.pm = fm + ((wgid % nig) % gsz); u.pn = (wgid % nig) / gsz; return true;
    }
};
struct GroupOrder {
    int G, c;
    __device__ __forceinline__ bool next(int i, Unit& u) const { const int L0 = i * G + c; if (L0 >= 256) return false; const int L = (G == 256) ? ((L0 & 7) * 32 + (L0 >> 3)) : L0; u.pm = L; u.pn = L >> 3; return true; }
};

__device__ __forceinline__ int perm32(int rho) { const int n = rho >> 4, i = rho & 15; return 8 * (i >> 2) + 4 * n + (i & 3); }
template <class Epi, class Sched, bool ROWPERM = false, bool PERMB = false>
__device__ __forceinline__ void gemm_phase(LAS unsigned char* lds, const Gemm g, const Sched& S, const Epi& E) {
    const int tid = threadIdx.x, wid = __builtin_amdgcn_readfirstlane(tid >> 6), lane = tid & 63, wr = wid >> 2, wc = wid & 3, fr = lane & 15, fq = lane >> 4;
    const int K = g.K, nt = K / BK;
    unsigned voffA[2], voffB[2];
#pragma unroll
    for (int i = 0; i < 2; ++i) { int R, C; stage_rc(tid * 16 + i * 8192, R, C); const int Ra = ROWPERM ? ((R & ~63) | ((R & 15) << 2) | ((R >> 4) & 3)) : R; const int Rb = PERMB ? ((R & ~31) + perm32(R & 31)) : R; voffA[i] = (unsigned)(Ra * g.lda + C) * 2u; voffB[i] = (unsigned)(Rb * g.ldb + C) * 2u; }
    const size_t kstep = (size_t)(BK * 2);
    const size_t hstepA = (size_t)HALF * g.lda * 2, hstepB = (size_t)HALF * g.ldb * 2;
    const size_t tstepA = 2 * hstepA, tstepB = 2 * hstepB;
    const unsigned ldsw = (unsigned)wid * 1024u;
    const int aoff = lds_byte(wr * 64 + fr, fq * 8), boff = lds_byte(wc * 32 + fr, fq * 8);
#define PG8_SA(b, h) (((b) * 2 + (h)) * HTB)
#define PG8_SB(b, h) ((4 + (b) * 2 + (h)) * HTB)
#define PG8_STAGE(bufoff, gbase, voff) do { _Pragma("unroll") for (int _i = 0; _i < 2; ++_i) \
        __builtin_amdgcn_global_load_lds((const unsigned*)((const char*)(gbase) + (voff)[_i]), (LAS unsigned*)(lds + (bufoff) + ldsw + _i * 8192), 16, 0, 0); } while (0)
#define PG8_LDA(dst, b, h) do { _Pragma("unroll") for (int m = 0; m < 4; ++m) _Pragma("unroll") for (int k = 0; k < 2; ++k) dst[m][k] = *(const LAS bf16x8*)(lds + PG8_SA(b, h) + aoff + m * 2048 + k * 1024); } while (0)
#define PG8_LDB(dst, b, h) do { _Pragma("unroll") for (int n = 0; n < 2; ++n) _Pragma("unroll") for (int k = 0; k < 2; ++k) dst[n][k] = *(const LAS bf16x8*)(lds + PG8_SB(b, h) + boff + n * 2048 + k * 1024); } while (0)
#define PG8_MMA(ai, bj, At, Bt) do { __builtin_amdgcn_s_setprio(1); _Pragma("unroll") for (int m = 0; m < 4; ++m) _Pragma("unroll") for (int n = 0; n < 2; ++n) _Pragma("unroll") for (int k = 0; k < 2; ++k) \
        acc[ai][bj][m][n] = __builtin_amdgcn_mfma_f32_16x16x32_bf16(Bt[n][k], At[m][k], acc[ai][bj][m][n], 0, 0, 0); __builtin_amdgcn_s_setprio(0); } while (0)
#define PG8_WAIT_V(n) asm volatile("s_waitcnt vmcnt(" #n ")" ::: "memory")
#define PG8_WAIT_L(n) asm volatile("s_waitcnt lgkmcnt(" #n ")" ::: "memory")
#define PG8_BAR __builtin_amdgcn_s_barrier()
#define PG8_SCHED __builtin_amdgcn_sched_barrier(0)
    Unit cur, nxt; int ui = 0;
    if (!S.next(0, cur)) return;
    f32x4 acc[2][2][4][2];
#pragma unroll
    for (int a = 0; a < 2; ++a)
#pragma unroll
        for (int b = 0; b < 2; ++b)
#pragma unroll
            for (int m = 0; m < 4; ++m)
#pragma unroll
                for (int n = 0; n < 2; ++n) acc[a][b][m][n] = (f32x4){0.f, 0.f, 0.f, 0.f};
    bf16x8 At[4][2], B0[2][2], B1[2][2];
    const char* cA = (const char*)g.A + (size_t)cur.pm * tstepA; const char* cB = (const char*)g.Bt + (size_t)cur.pn * tstepB;
    PG8_STAGE(PG8_SB(0, 0), cB, voffB); PG8_STAGE(PG8_SA(0, 0), cA, voffA); PG8_STAGE(PG8_SB(0, 1), cB + hstepB, voffB); PG8_STAGE(PG8_SA(0, 1), cA + hstepA, voffA);
    if (wr == 1) PG8_BAR;
    PG8_WAIT_V(4); PG8_BAR;
    PG8_STAGE(PG8_SB(1, 0), cB + kstep, voffB); PG8_STAGE(PG8_SA(1, 0), cA + kstep, voffA); PG8_STAGE(PG8_SB(1, 1), cB + hstepB + kstep, voffB);
    PG8_WAIT_V(6); PG8_BAR;
    for (;;) {
        const bool has_next = S.next(ui + 1, nxt);
        const char* nA = has_next ? (const char*)g.A + (size_t)nxt.pm * tstepA : cA; const char* nB = has_next ? (const char*)g.Bt + (size_t)nxt.pn * tstepB : cB;
        for (int t = 0; t < nt; t += 2) {
            const bool last = (t == nt - 2);
            const char* a1 = cA + (size_t)(t + 1) * kstep;
            const char* a2 = last ? nA : cA + (size_t)(t + 2) * kstep; const char* b2 = last ? nB : cB + (size_t)(t + 2) * kstep;
            const char* a3 = a2 + kstep; const char* b3 = b2 + kstep;
            PG8_LDB(B0, 0, 0); PG8_SCHED; PG8_LDA(At, 0, 0); PG8_STAGE(PG8_SA(1, 1), a1 + hstepA, voffA);
            PG8_WAIT_L(8); PG8_BAR; PG8_WAIT_L(0); PG8_MMA(0, 0, At, B0); PG8_BAR; PG8_SCHED;
            PG8_LDB(B1, 0, 1); PG8_STAGE(PG8_SB(0, 0), b2, voffB);
            PG8_BAR; PG8_WAIT_L(0); PG8_MMA(0, 1, At, B1); PG8_BAR;
            PG8_LDA(At, 0, 1); PG8_STAGE(PG8_SA(0, 0), a2, voffA);
            PG8_BAR; PG8_WAIT_L(0); PG8_MMA(1, 0, At, B0); PG8_BAR; PG8_SCHED;
            PG8_STAGE(PG8_SB(0, 1), b2 + hstepB, voffB);
            PG8_WAIT_V(6); PG8_BAR; PG8_MMA(1, 1, At, B1); PG8_BAR;
            PG8_LDB(B0, 1, 0); PG8_SCHED; PG8_LDA(At, 1, 0); PG8_STAGE(PG8_SA(0, 1), a2 + hstepA, voffA);
            PG8_WAIT_L(8); PG8_BAR; PG8_WAIT_L(0); PG8_MMA(0, 0, At, B0); PG8_BAR; PG8_SCHED;
            PG8_LDB(B1, 1, 1); PG8_STAGE(PG8_SB(1, 0), b3, voffB);
            PG8_BAR; PG8_WAIT_L(0); PG8_MMA(0, 1, At, B1); PG8_BAR;
            PG8_LDA(At, 1, 1); PG8_STAGE(PG8_SA(1, 0), a3, voffA);
            PG8_BAR; PG8_WAIT_L(0); PG8_MMA(1, 0, At, B0); PG8_BAR; PG8_SCHED;
            PG8_STAGE(PG8_SB(1, 1), b3 + hstepB, voffB);
            PG8_WAIT_V(6); PG8_BAR; PG8_MMA(1, 1, At, B1); PG8_BAR;
        }
        E(acc, cur, wr, wc, fr, fq);
        if (!has_next) break;
#pragma unroll
        for (int a = 0; a < 2; ++a)
#pragma unroll
            for (int b = 0; b < 2; ++b)
#pragma unroll
                for (int m = 0; m < 4; ++m)
#pragma unroll
                    for (int n = 0; n < 2; ++n) acc[a][b][m][n] = (f32x4){0.f, 0.f, 0.f, 0.f};
        cur = nxt; cA = nA; cB = nB; ++ui;
    }
    PG8_WAIT_V(0);
    if (wr == 0) PG8_BAR;
    PG8_BAR;
#undef PG8_SA
#undef PG8_SB
#undef PG8_STAGE
#undef PG8_LDA
#undef PG8_LDB
#undef PG8_MMA
#undef PG8_WAIT_V
#undef PG8_WAIT_L
#undef PG8_BAR
#undef PG8_SCHED
}
}
using pg8::Unit;
typedef f32x4 Acc[2][2][4][2];

__device__ __forceinline__ void arrive_wait(unsigned* cnt, unsigned want) {
    asm volatile("s_waitcnt vmcnt(0)" ::: "memory");
    if ((threadIdx.x & 63) == 0) __hip_atomic_fetch_add(cnt, 1u, __ATOMIC_RELAXED, __HIP_MEMORY_SCOPE_AGENT);
    unsigned sp = 0;
    while (__hip_atomic_load(cnt, __ATOMIC_RELAXED, __HIP_MEMORY_SCOPE_AGENT) < want) { __builtin_amdgcn_s_sleep(1); if (++sp > (1u << 21)) break; }
    asm volatile("" ::: "memory");
}
__device__ __forceinline__ float ld_agent(const float* p) { return __hip_atomic_load(p, __ATOMIC_RELAXED, __HIP_MEMORY_SCOPE_AGENT); }

struct EpiIn {
    bf16_t *q, *k, *v, *uh; float* us; const float* rope; float* out;
    __device__ __forceinline__ void operator()(const Acc& acc, const Unit& u, int wr, int wc, int fr_, int fq_) const { int lz; asm volatile("v_mov_b32 %0, 0" : "=v"(lz)); const int lane_ = __builtin_amdgcn_mbcnt_hi(~0u, __builtin_amdgcn_mbcnt_lo(~0u, lz)); const int fr = lane_ & 15, fq = lane_ >> 4;
        const int pn = u.pn;
#pragma unroll
        for (int ai = 0; ai < 2; ++ai)
#pragma unroll
            for (int m = 0; m < 4; ++m) {
                const int r = u.pm * 256 + ai * 128 + wr * 64 + m * 16 + fr;
                const bool samp = r >= NPR;
                const int rs_ = r - NPR;
                const int pos = samp ? 2048 + (rs_ & 15) : (r & 8191);
                if (pn <= 2) {
#pragma unroll
                    for (int bj = 0; bj < 2; ++bj) {
                        if (pn == 2 && bj == 1) {
#pragma unroll
                            for (int n = 0; n < 2; ++n) {
                                const int cv = wc * 32 + n * 16 + fq * 4; const f32x4 val = acc[ai][1][m][n];
                                *(u32x2*)(v + (size_t)r * 128 + cv) = pk4(val);
                                if (!samp) { const int t = r & 8191, b = r >> 13; if (t >= 8064) st4(out + O_VP + ((size_t)(b * 128 + t - 8064)) * 128 + cv, val); }
                                else { const int b = rs_ >> 4, s = rs_ & 15; st4(out + O_VS + ((size_t)(b * 128 + 112 + s)) * 128 + cv, val); }
                            }
                        } else {
                            const int wg = (pn == 2) ? wc : (bj * 4 + wc);
                            const int hl = wg >> 1, dbase = 16 * (wg & 1) + 4 * fq;
                            const f32x4 cs = ld4(rope + pos * 32 + dbase), sn = ld4(rope + 262144 + pos * 32 + dbase);
                            const f32x4 x1 = acc[ai][bj][m][0], x2 = acc[ai][bj][m][1];
                            const f32x4 o1 = x1 * cs - x2 * sn, o2 = x2 * cs + x1 * sn;
                            if (pn < 2) { bf16_t* dst = q + (size_t)r * 512 + (pn * 4 + hl) * 64 + dbase; *(u32x2*)dst = pk4(o1); *(u32x2*)(dst + 32) = pk4(o2); }
                            else {
                                const int cc = hl * 64 + dbase; bf16_t* dst = k + (size_t)r * 128 + cc; *(u32x2*)dst = pk4(o1); *(u32x2*)(dst + 32) = pk4(o2);
                                if (!samp) { const int t = r & 8191, b = r >> 13; if (t >= 8064) { float* o = out + O_KP + ((size_t)(b * 128 + t - 8064)) * 128 + cc; st4(o, o1); st4(o + 32, o2); } }
                                else { const int b = rs_ >> 4, s = rs_ & 15; float* o = out + O_KS + ((size_t)(b * 128 + 112 + s)) * 128 + cc; st4(o, o1); st4(o + 32, o2); }
                            }
                        }
                    }
                } else {
#pragma unroll
                    for (int bj = 0; bj < 2; ++bj)
#pragma unroll
                        for (int n = 0; n < 2; ++n) {
                            const int cu = 256 * (pn - 3) + 128 * bj + 32 * wc + 16 * n + 4 * fq; const int g = cu >> 4, c = cu & 15;
                            if (!samp) *(u32x2*)(uh + ((size_t)(g * 2048 + (r >> 4))) * 384 + (r & 15) * 16 + c) = pk4(acc[ai][bj][m][n]);
                            else st4(us + (size_t)rs_ * 512 + cu, acc[ai][bj][m][n]);
                        }
                }
            }
    }
};
struct EpiS {
    bf16_t* sb;
    __device__ __forceinline__ void operator()(const Acc& acc, const Unit& u, int wr, int wc, int fr_, int fq_) const { int lz; asm volatile("v_mov_b32 %0, 0" : "=v"(lz)); const int lane_ = __builtin_amdgcn_mbcnt_hi(~0u, __builtin_amdgcn_mbcnt_lo(~0u, lz)); const int fr = lane_ & 15, fq = lane_ >> 4;
#pragma unroll
        for (int ai = 0; ai < 2; ++ai)
#pragma unroll
            for (int m = 0; m < 4; ++m) {
                const int R = u.pm * 256 + ai * 128 + wr * 64 + m * 16 + fr;
#pragma unroll
                for (int n = 0; n < 2; ++n) *(u32x2*)(sb + (size_t)R * 128 + wc * 32 + n * 16 + fq * 4) = pk4(acc[ai][0][m][n]);
            }
    }
};
struct EpiY {
    bf16_t* z;
    __device__ __forceinline__ void operator()(const Acc& acc, const Unit& u, int wr, int wc, int fr_, int fq_) const {
        int lz; asm volatile("v_mov_b32 %0, 0" : "=v"(lz)); const int lane_ = __builtin_amdgcn_mbcnt_hi(~0u, __builtin_amdgcn_mbcnt_lo(~0u, lz)); const int fr = lane_ & 15, fq = lane_ >> 4;
#pragma unroll
        for (int ai = 0; ai < 2; ++ai)
#pragma unroll
            for (int m = 0; m < 4; ++m) {
                const int R = u.pm * 256 + ai * 128 + wr * 64 + m * 16 + fr; const int chunk = R & 2047, g = R >> 11;
#pragma unroll
                for (int bj = 0; bj < 2; ++bj) {
                    const int t = 8 * bj + 2 * wc + (fq >> 1); f32x4 y0 = acc[ai][bj][m][0], y1 = acc[ai][bj][m][1];
#pragma unroll
                    for (int i = 0; i < 4; ++i) { y0[i] = gelu_tanh(y0[i]); y1[i] = gelu_tanh(y1[i]); }
                    const u32x2 p0 = pk4(y0), p1 = pk4(y1); u32x4 w; w.x = p0.x; w.y = p0.y; w.z = p1.x; w.w = p1.y;
                    *(u32x4*)(z + ((size_t)(chunk * 16 + t)) * 512 + g * 16 + 8 * (fq & 1)) = w;
                }
            }
    }
};
struct EpiGlu {
    const bf16_t* z; bf16_t* mrg; float* rss; unsigned* cnt;
    __device__ __forceinline__ void operator()(Acc& acc, const Unit& u, int wr, int wc, int fr_, int fq_) const {
        int lz; asm volatile("v_mov_b32 %0, 0" : "=v"(lz)); const int lane_ = __builtin_amdgcn_mbcnt_hi(~0u, __builtin_amdgcn_mbcnt_lo(~0u, lz)); const int fr = lane_ & 15, fq = lane_ >> 4;
#pragma unroll
        for (int ai = 0; ai < 2; ++ai)
#pragma unroll
            for (int m = 0; m < 4; ++m) {
                const int r = u.pm * 256 + ai * 128 + wr * 64 + m * 16 + fr;
#pragma unroll
                for (int bj = 0; bj < 2; ++bj) {
                    const int col = u.pn * 256 + bj * 128 + wc * 32 + fq * 8;
                    const u32x4 zw = *(const u32x4*)(z + (size_t)r * 512 + col); const f32x4 a0 = acc[ai][bj][m][0], a1 = acc[ai][bj][m][1];
                    f32x4 o0, o1; o0[0] = bflo(zw.x) * sigmoidf(a0[0]); o0[1] = bfhi(zw.x) * sigmoidf(a0[1]); o0[2] = bflo(zw.y) * sigmoidf(a0[2]); o0[3] = bfhi(zw.y) * sigmoidf(a0[3]);
                    o1[0] = bflo(zw.z) * sigmoidf(a1[0]); o1[1] = bfhi(zw.z) * sigmoidf(a1[1]); o1[2] = bflo(zw.w) * sigmoidf(a1[2]); o1[3] = bfhi(zw.w) * sigmoidf(a1[3]);
                    acc[ai][bj][m][0] = o0; acc[ai][bj][m][1] = o1;
                }
                if (m == 3) __builtin_amdgcn_sched_barrier(0);
            }
#pragma unroll
        for (int ai = 0; ai < 2; ++ai)
#pragma unroll
            for (int m = 0; m < 4; ++m) {
                const int r = u.pm * 256 + ai * 128 + wr * 64 + m * 16 + fr; float ssq = 0.f;
#pragma unroll
                for (int bj = 0; bj < 2; ++bj)
#pragma unroll
                    for (int n = 0; n < 2; ++n) { const f32x4 o = acc[ai][bj][m][n]; ssq += (o[0] * o[0] + o[1] * o[1]) + (o[2] * o[2] + o[3] * o[3]); }
                ssq += __shfl_xor(ssq, 16); ssq += __shfl_xor(ssq, 32);
                if (fq == 0) atomicAdd(rss + r, ssq);
            }
        arrive_wait(cnt + (256 + u.pm * 2 + wr) * 16, 8u);
#pragma unroll
        for (int ai = 0; ai < 2; ++ai)
#pragma unroll
            for (int m = 0; m < 4; ++m) {
                const int r = u.pm * 256 + ai * 128 + wr * 64 + m * 16 + fr;
                const float rstd = rsqrtf(ld_agent(rss + r) * (1.0f / 512.0f) + EPS);
#pragma unroll
                for (int bj = 0; bj < 2; ++bj) {
                    const int col = u.pn * 256 + bj * 128 + wc * 32 + fq * 8;
                    const u32x2 p0 = pk4(acc[ai][bj][m][0] * rstd), p1 = pk4(acc[ai][bj][m][1] * rstd); u32x4 w; w.x = p0.x; w.y = p0.y; w.z = p1.x; w.w = p1.y;
                    *(u32x4*)(mrg + (size_t)r * 1024 + 512 + col) = w;
                }
            }
    }
};
struct EpiOut {
    const float* xp; const float* xs; bf16_t* x1b; float* rss; unsigned* cnt;
    __device__ __forceinline__ void operator()(Acc& acc, const Unit& u, int wr, int wc, int fr_, int fq_) const {
        int lz; asm volatile("v_mov_b32 %0, 0" : "=v"(lz)); const int lane_ = __builtin_amdgcn_mbcnt_hi(~0u, __builtin_amdgcn_mbcnt_lo(~0u, lz)); const int fr = lane_ & 15, fq = lane_ >> 4;
#pragma unroll
        for (int ai = 0; ai < 2; ++ai)
#pragma unroll
            for (int m = 0; m < 4; ++m) {
                const int r = u.pm * 256 + ai * 128 + wr * 64 + m * 16 + fr; float ssq = 0.f;
                const float* xr = xp + (size_t)r * 1024;
#pragma unroll
                for (int bj = 0; bj < 2; ++bj)
#pragma unroll
                    for (int n = 0; n < 2; ++n) {
                        const int col = u.pn * 256 + bj * 128 + wc * 32 + fq * 8 + n * 4;
                        const f32x4 o = ld4(xr + col) + acc[ai][bj][m][n];
                        ssq += (o[0] * o[0] + o[1] * o[1]) + (o[2] * o[2] + o[3] * o[3]);
                        acc[ai][bj][m][n] = o;
                    }
                ssq += __shfl_xor(ssq, 16); ssq += __shfl_xor(ssq, 32);
                if (fq == 0) atomicAdd(rss + r, ssq);
            }
        arrive_wait(cnt + (528 + u.pm * 2 + wr) * 16, 16u);
#pragma unroll
        for (int ai = 0; ai < 2; ++ai)
#pragma unroll
            for (int m = 0; m < 4; ++m) {
                const int r = u.pm * 256 + ai * 128 + wr * 64 + m * 16 + fr;
                const float rstd = rsqrtf(ld_agent(rss + r) * (1.0f / 1024.0f) + EPS);
#pragma unroll
                for (int bj = 0; bj < 2; ++bj) {
                    const int col = u.pn * 256 + bj * 128 + wc * 32 + fq * 8;
                    const u32x2 p0 = pk4(acc[ai][bj][m][0] * rstd), p1 = pk4(acc[ai][bj][m][1] * rstd); u32x4 w; w.x = p0.x; w.y = p0.y; w.z = p1.x; w.w = p1.y;
                    *(u32x4*)(x1b + (size_t)r * 1024 + col) = w;
                }
            }
    }
};
struct EpiUp {
    const float* cw; const float* cb; bf16_t* hb; float* eb;
    __device__ __forceinline__ void operator()(const Acc& acc, const Unit& u, int wr, int wc, int fr_, int fq_) const {
        int lz; asm volatile("v_mov_b32 %0, 0" : "=v"(lz));
        const int lane = __builtin_amdgcn_mbcnt_hi(~0u, __builtin_amdgcn_mbcnt_lo(~0u, lz));
        const int fr = lane & 15, fq = lane >> 4;
#define DPPR1(v) __int_as_float(__builtin_amdgcn_update_dpp(0, __float_as_int(v), 0x121, 0xF, 0xF, true))
        const int cbase = u.pn * 128 + wc * 32 + fq * 8;
        f32x4 wg[2][4], wv[2][4];
#pragma unroll
        for (int n = 0; n < 2; ++n) {
            const int cg = cbase + n * 4, cv = DFF + cg;
            wg[n][0] = ld4(cw + cg); wg[n][1] = ld4(cw + DFF2 + cg); wg[n][2] = ld4(cw + 2 * DFF2 + cg); wg[n][3] = ld4(cb + cg);
            wv[n][0] = ld4(cw + cv); wv[n][1] = ld4(cw + DFF2 + cv); wv[n][2] = ld4(cw + 2 * DFF2 + cv); wv[n][3] = ld4(cb + cv);
        }
#pragma unroll
        for (int ai = 0; ai < 2; ++ai)
#pragma unroll
            for (int bj = 0; bj < 2; ++bj)
#pragma unroll
                for (int n = 0; n < 2; ++n) {
                    const int jblk = u.pm * 4 + ai * 2 + wr; const int col = bj * DFF + cbase + n * 4;
                    if (fr == 0) { st4(eb + ((size_t)jblk * 4 + 0) * DFF2 + col, acc[ai][bj][0][n]); st4(eb + ((size_t)jblk * 4 + 1) * DFF2 + col, acc[ai][bj][1][n]); }
                    if (fr == 15) { st4(eb + ((size_t)jblk * 4 + 2) * DFF2 + col, acc[ai][bj][2][n]); st4(eb + ((size_t)jblk * 4 + 3) * DFF2 + col, acc[ai][bj][3][n]); }
                }
        __builtin_amdgcn_sched_barrier(0);
#pragma unroll
        for (int ai = 0; ai < 2; ++ai) {
            const int r0 = u.pm * 256 + ai * 128 + wr * 64 + 4 * fr;
            u32x2 pk[2][4];
#pragma unroll
            for (int n = 0; n < 2; ++n) {
                const f32x4 w0g = wg[n][0], w1g = wg[n][1], w2g = wg[n][2], bg = wg[n][3], w0v = wv[n][0], w1v = wv[n][1], w2v = wv[n][2], bv = wv[n][3];
                const f32x4 g0 = acc[ai][0][0][n], g1 = acc[ai][0][1][n], g2 = acc[ai][0][2][n], g3 = acc[ai][0][3][n];
                const f32x4 v0 = acc[ai][1][0][n], v1 = acc[ai][1][1][n], v2 = acc[ai][1][2][n], v3 = acc[ai][1][3][n];
                f32x4 qg2, qg3, qv2, qv3;
#pragma unroll
                for (int i = 0; i < 4; ++i) { qg2[i] = DPPR1(g2[i]); qg3[i] = DPPR1(g3[i]); qv2[i] = DPPR1(v2[i]); qv3[i] = DPPR1(v3[i]); }
                const f32x4 cg0 = w2g * g0 + w1g * qg3 + w0g * qg2 + bg, cv0 = w2v * v0 + w1v * qv3 + w0v * qv2 + bv;
                const f32x4 cg1 = w2g * g1 + w1g * g0 + w0g * qg3 + bg, cv1 = w2v * v1 + w1v * v0 + w0v * qv3 + bv;
                const f32x4 cg2 = w2g * g2 + w1g * g1 + w0g * g0 + bg, cv2 = w2v * v2 + w1v * v1 + w0v * v0 + bv;
                const f32x4 cg3 = w2g * g3 + w1g * g2 + w0g * g1 + bg, cv3 = w2v * v3 + w1v * v2 + w0v * v1 + bv;
                f32x4 h0, h1, h2, h3;
#pragma unroll
                for (int i = 0; i < 4; ++i) { h0[i] = cg0[i] * sigmoidf(cg0[i]) * cv0[i]; h1[i] = cg1[i] * sigmoidf(cg1[i]) * cv1[i]; h2[i] = cg2[i] * sigmoidf(cg2[i]) * cv2[i]; h3[i] = cg3[i] * sigmoidf(cg3[i]) * cv3[i]; }
                pk[n][0] = pk4(h0); pk[n][1] = pk4(h1); pk[n][2] = pk4(h2); pk[n][3] = pk4(h3);
            }
            bf16_t* hp = hb + (size_t)r0 * DFF + cbase;
#pragma unroll
            for (int m = 0; m < 4; ++m) { u32x4 w; w.x = pk[0][m].x; w.y = pk[0][m].y; w.z = pk[1][m].x; w.w = pk[1][m].y; *(u32x4*)(hp + (size_t)m * DFF) = w; }
            __builtin_amdgcn_sched_barrier(0);
        }
#undef DPPR1
    }
};
struct EpiDown {
    const bf16_t* x1b; float* out; float* rss; unsigned* cnt; const float* fg; const float* rss2;
    __device__ __forceinline__ void operator()(Acc& acc, const Unit& u, int wr, int wc, int fr_, int fq_) const {
        int lz; asm volatile("v_mov_b32 %0, 0" : "=v"(lz)); const int lane_ = __builtin_amdgcn_mbcnt_hi(~0u, __builtin_amdgcn_mbcnt_lo(~0u, lz)); const int fr = lane_ & 15, fq = lane_ >> 4;
#pragma unroll
        for (int ai = 0; ai < 2; ++ai)
#pragma unroll
            for (int m = 0; m < 4; ++m) {
                const int r = u.pm * 256 + ai * 128 + wr * 64 + m * 16 + fr;
                const float inv2 = sqrtf(rss2[r] * (1.0f / 1024.0f) + EPS);
#pragma unroll
                for (int bj = 0; bj < 2; ++bj)
#pragma unroll
                    for (int n = 0; n < 2; ++n) {
                        const int col = u.pn * 256 + bj * 128 + wc * 32 + n * 16 + fq * 4;
                        const u32x2 xw = *(const u32x2*)(x1b + (size_t)r * 1024 + col); f32x4 o = acc[ai][bj][m][n];
                        o[0] += bflo(xw.x) * inv2; o[1] += bfhi(xw.x) * inv2; o[2] += bflo(xw.y) * inv2; o[3] += bfhi(xw.y) * inv2;
                        acc[ai][bj][m][n] = o;
                    }
                if (m == 3) __builtin_amdgcn_sched_barrier(0);
            }
#pragma unroll
        for (int ai = 0; ai < 2; ++ai)
#pragma unroll
            for (int m = 0; m < 4; ++m) {
                const int r = u.pm * 256 + ai * 128 + wr * 64 + m * 16 + fr; float ssq = 0.f;
#pragma unroll
                for (int bj = 0; bj < 2; ++bj)
#pragma unroll
                    for (int n = 0; n < 2; ++n) { const f32x4 o = acc[ai][bj][m][n]; ssq += (o[0] * o[0] + o[1] * o[1]) + (o[2] * o[2] + o[3] * o[3]); }
                ssq += __shfl_xor(ssq, 16); ssq += __shfl_xor(ssq, 32);
                if (fq == 0) atomicAdd(rss + r, ssq);
            }
        f32x4 gf[2][2];
#pragma unroll
        for (int bj = 0; bj < 2; ++bj)
#pragma unroll
            for (int n = 0; n < 2; ++n) gf[bj][n] = ld4(fg + u.pn * 256 + bj * 128 + wc * 32 + n * 16 + fq * 4);
        arrive_wait(cnt + (u.pm * 2 + wr) * 16, 16u);
#pragma unroll
        for (int ai = 0; ai < 2; ++ai)
#pragma unroll
            for (int m = 0; m < 4; ++m) {
                const int r = u.pm * 256 + ai * 128 + wr * 64 + m * 16 + fr;
                const float rstd = rsqrtf(ld_agent(rss + r) * (1.0f / 1024.0f) + EPS);
#pragma unroll
                for (int bj = 0; bj < 2; ++bj)
#pragma unroll
                    for (int n = 0; n < 2; ++n) {
                        const int col = u.pn * 256 + bj * 128 + wc * 32 + n * 16 + fq * 4;
                        __builtin_nontemporal_store(acc[ai][bj][m][n] * rstd * gf[bj][n], (f32x4*)(out + (size_t)r * 1024 + col));
                    }
            }
    }
};

__device__ __forceinline__ int ropeperm(int nl) { return 16 * (nl >> 5) + 32 * ((nl >> 4) & 1) + (nl & 15); }
struct TrTile { const float* src; bf16_t* dst; const float* gain; int ldsrc, K, kt, srcc0, dstn0, perm; };
__device__ __forceinline__ TrTile p0_tile(const P& p, unsigned char* ws, int t) {
    TrTile T; T.gain = nullptr; T.perm = 0;
    if (t < 320) { const int kt = t / 20, gq = t % 20; T.src = p.w_in; T.ldsrc = 1280; T.dst = (bf16_t*)(ws + WS_WIN); T.K = 1024; T.kt = kt; T.srcc0 = gq * 64; T.dstn0 = gq * 64; T.perm = (gq < 10) ? 1 : 0; }
    else if (t < 384) { const int u = t - 320, kt = u / 8, gq = u % 8; T.src = p.w_glu; T.ldsrc = 512; T.dst = (bf16_t*)(ws + WS_WGLU); T.K = 512; T.kt = kt; T.srcc0 = gq * 64; T.dstn0 = gq * 64; }
    else if (t < 640) { const int u = t - 384, kt = u / 16, gq = u % 16; T.src = p.w_out; T.ldsrc = 1024; T.dst = (bf16_t*)(ws + WS_WOUT); T.K = 1024; T.kt = kt; T.srcc0 = gq * 64; T.dstn0 = gq * 64; if (kt >= 8) T.gain = p.on_s - 512; }
    else if (t < 2048) { const int u = t - 640, kt = u / 88, gq = u % 88; const int pn = gq >> 2, q4 = gq & 3;
        T.src = p.w_up; T.ldsrc = DFF2; T.dst = (bf16_t*)(ws + WS_WUP); T.K = 1024; T.kt = kt; T.srcc0 = (q4 < 2) ? pn * 128 + q4 * 64 : DFF + pn * 128 + (q4 - 2) * 64; T.dstn0 = gq * 64; T.gain = p.norm2_g; }
    else { const int u = t - 2048, kt = u / 16, gq = u % 16; T.src = p.w_down; T.ldsrc = 1024; T.dst = (bf16_t*)(ws + WS_WDOWN); T.K = DFF; T.kt = kt; T.srcc0 = gq * 64; T.dstn0 = gq * 64; }
    return T;
}
__device__ __forceinline__ void p0_tr_load(const TrTile& T, f32x4 (&v)[2]) {
    const int tid = threadIdx.x;
#pragma unroll
    for (int i = 0; i < 2; ++i) { const int idx = tid + i * NTHR; const int kr = idx >> 4, c4 = (idx & 15) * 4;
        v[i] = ld4(T.src + (size_t)(T.kt * 64 + kr) * T.ldsrc + T.srcc0 + c4);
        if (T.gain) v[i] *= T.gain[T.kt * 64 + kr]; }
}
__device__ __forceinline__ void p0_tr_store(LAS float* tile, const TrTile& T, const f32x4 (&v)[2]) {
    const int tid = threadIdx.x;
#pragma unroll
    for (int i = 0; i < 2; ++i) { const int idx = tid + i * NTHR; const int kr = idx >> 4, c4 = (idx & 15) * 4;
        tile[kr * 65 + c4 + 0] = v[i][0]; tile[kr * 65 + c4 + 1] = v[i][1]; tile[kr * 65 + c4 + 2] = v[i][2]; tile[kr * 65 + c4 + 3] = v[i][3]; }
    __syncthreads();
    const int nl = tid >> 3, ks = (tid & 7) * 8; const int sl = T.perm ? ropeperm(nl) : nl;
    u32x4 w;
    w.x = pk2(tile[(ks + 0) * 65 + sl], tile[(ks + 1) * 65 + sl]); w.y = pk2(tile[(ks + 2) * 65 + sl], tile[(ks + 3) * 65 + sl]);
    w.z = pk2(tile[(ks + 4) * 65 + sl], tile[(ks + 5) * 65 + sl]); w.w = pk2(tile[(ks + 6) * 65 + sl], tile[(ks + 7) * 65 + sl]);
    *(u32x4*)(T.dst + (size_t)(T.dstn0 + nl) * T.K + T.kt * 64 + ks) = w;
    __syncthreads();
}

__device__ __forceinline__ void p0_tr_range(LAS unsigned char* lds, const P& p, int t0, int stride, int t1) {
    LAS float* tile = (LAS float*)lds; unsigned char* ws = p.ws;
    int t = t0;
    if (t < t1) {
        TrTile T = p0_tile(p, ws, t); f32x4 v[2]; p0_tr_load(T, v);
        for (;;) {
            const int tn = t + stride; const bool more = tn < t1;
            TrTile Tn = T; f32x4 vn[2] = {v[0], v[1]};
            if (more) { Tn = p0_tile(p, ws, tn); p0_tr_load(Tn, vn); }
            p0_tr_store(tile, T, v);
            if (!more) break;
            T = Tn; v[0] = vn[0]; v[1] = vn[1]; t = tn;
        }
    }
}

__device__ __forceinline__ void phase0(LAS unsigned char* lds, const P& p) {
    unsigned char* ws = p.ws;
    const int tid = threadIdx.x, lane = tid & 63, wave = tid >> 6;
    const int G = gridDim.x, blk = blockIdx.x;
    const size_t gtid = (size_t)blk * NTHR + tid, gstride = (size_t)G * NTHR;
    { float* z = (float*)(ws + WS_RSS_S); const size_t n = (WS_ROPE - WS_RSS_S) / 4; for (size_t i = gtid; i < n; i += gstride) z[i] = 0.f; }
    { float* rope = (float*)(ws + WS_ROPE);
      for (size_t i = gtid; i < 8192 * 32; i += gstride) { const int pos = (int)(i >> 5), f = (int)(i & 31);
          const float inv = powf(10000.0f, -(float)f / 32.0f); const float ang = (float)pos * inv; float s, c; sincosf(ang, &s, &c); rope[i] = c; rope[262144 + i] = s; } }
    { for (size_t i = gtid; i < (size_t)16 * 112 * 128; i += gstride) { const size_t b = i / (112 * 128), rem = i % (112 * 128);
          p.out[O_KS + b * 16384 + rem] = p.cache_k[b * 16384 + 2048 + rem]; p.out[O_VS + b * 16384 + rem] = p.cache_v[b * 16384 + 2048 + rem]; } }
    p0_tr_range(lds, p, blk, G, 320);
    { bf16_t* xn = (bf16_t*)(ws + WS_XN1);
      const int nsk = (G > 2 * NG) ? NG : 0;
      if (blk >= nsk) for (int r4 = ((blk - nsk) * 8 + wave) * 4; r4 < MR; r4 += (G - nsk) * 32) {
          f32x4 v[4][4]; float ss[4];
#pragma unroll
          for (int q = 0; q < 4; ++q) { const int r = r4 + q; const float* xr = (r < NPR) ? p.x_prompt + (size_t)r * 1024 : p.x_sample + (size_t)(r - NPR) * 1024;
#pragma unroll
              for (int i = 0; i < 4; ++i) v[q][i] = ld4(xr + i * 256 + lane * 4); }
#pragma unroll
          for (int q = 0; q < 4; ++q) { float a = 0.f;
#pragma unroll
              for (int i = 0; i < 4; ++i) a += (v[q][i][0] * v[q][i][0] + v[q][i][1] * v[q][i][1]) + (v[q][i][2] * v[q][i][2] + v[q][i][3] * v[q][i][3]);
              ss[q] = rsqrtf(wsum(a) * (1.0f / 1024.0f) + EPS); }
#pragma unroll
          for (int i = 0; i < 4; ++i) { const f32x4 g = ld4(p.norm1_g + i * 256 + lane * 4);
#pragma unroll
              for (int q = 0; q < 4; ++q) *(u32x2*)(xn + (size_t)(r4 + q) * 1024 + i * 256 + lane * 4) = pk4(v[q][i] * ss[q] * g); }
      } }
    __syncthreads();
    for (int g = blk; g < NG; g += G) {
        LAS float* lamre = (LAS float*)lds;
        LAS float* lamim = lamre + 17 * 64;
        LAS float* coef = lamim + 17 * 64;
        LAS float* bbre = coef + 128;
        LAS float* bbim = bbre + 1024;
        LAS float* cre = bbim + 1024;
        LAS float* cim = cre + 1024;
        LAS float* km = cim + 1024;
        float* lamT = (float*)(ws + WS_LAM); float* bbar = (float*)(ws + WS_BBAR);
        if (tid < 64) {
            const int pp = tid; const float dt = expf(p.log_dt[g]); const float ar = p.A_re[g * 64 + pp], ai = p.A_im[g * 64 + pp];
            for (int k = 0; k <= 16; ++k) { const float mag = expf((float)k * dt * ar); float s, c; sincosf((float)k * dt * ai, &s, &c); lamre[k * 64 + pp] = mag * c; lamim[k * 64 + pp] = mag * s; }
            const float lr = lamre[64 + pp] - 1.0f, li = lamim[64 + pp], den = ar * ar + ai * ai;
            coef[pp] = (lr * ar + li * ai) / den; coef[64 + pp] = (li * ar - lr * ai) / den;
            float* lt = lamT + (size_t)(g * 64 + pp) * 4; lt[0] = lamre[64 + pp]; lt[1] = lamim[64 + pp]; lt[2] = lamre[16 * 64 + pp]; lt[3] = lamim[16 * 64 + pp];
        }
        __syncthreads();
        for (int e = tid; e < 1024; e += NTHR) {
            const int pp = e >> 4; const float br = p.B_re[g * 1024 + e], bi = p.B_im[g * 1024 + e], cr = coef[pp], ci = coef[64 + pp];
            const float vr = cr * br - ci * bi, vi = cr * bi + ci * br; bbre[e] = vr; bbim[e] = vi;
            bbar[((size_t)g * 1024 + e) * 2] = vr; bbar[((size_t)g * 1024 + e) * 2 + 1] = vi;
            cre[e] = p.C_re[g * 1024 + e]; cim[e] = p.C_im[g * 1024 + e];
        }
        __syncthreads();
        for (int e = tid; e < 4096; e += NTHR) {
            const int tau = e >> 8, co = (e >> 4) & 15, ci = e & 15; float sum = 0.f;
            for (int pp = 0; pp < 64; ++pp) { const float c_r = cre[co * 64 + pp], c_i = cim[co * 64 + pp], l_r = lamre[tau * 64 + pp], l_i = lamim[tau * 64 + pp];
                const float clr = c_r * l_r - c_i * l_i, cli = c_r * l_i + c_i * l_r; sum += clr * bbre[pp * 16 + ci] - cli * bbim[pp * 16 + ci]; }
            if (tau == 0 && co == ci) sum += p.Dskip[g * 16 + co];
            km[e] = sum;
        }
        __syncthreads();
        bf16_t* wy = (bf16_t*)(ws + WS_WY) + (size_t)g * 256 * 384;
        for (int v = tid; v < 256 * 48; v += NTHR) {
            const int n = v / 48, k0 = (v % 48) * 8; const int t = n >> 4, co = n & 15; float f[8];
            if (k0 < 256) { const int s = k0 >> 4, ci0 = k0 & 15;
#pragma unroll
                for (int j = 0; j < 8; ++j) f[j] = (s <= t) ? km[((t - s) << 8) + (co << 4) + ci0 + j] : 0.f;
            } else { const int j0 = k0 - 256;
#pragma unroll
                for (int j = 0; j < 8; ++j) { const int jj = j0 + j, pp = jj & 63; const float c_r = cre[co * 64 + pp], c_i = cim[co * 64 + pp], l_r = lamre[(t + 1) * 64 + pp], l_i = lamim[(t + 1) * 64 + pp];
                    f[j] = (jj < 64) ? (c_r * l_r - c_i * l_i) : -(c_r * l_i + c_i * l_r); }
            }
            u32x4 w; w.x = pk2(f[0], f[1]); w.y = pk2(f[2], f[3]); w.z = pk2(f[4], f[5]); w.w = pk2(f[6], f[7]);
            *(u32x4*)(wy + (size_t)n * 384 + k0) = w;
        }
        bf16_t* wsm = (bf16_t*)(ws + WS_WS) + (size_t)g * 256 * 256;
        for (int v = tid; v < 256 * 32; v += NTHR) {
            const int n = v >> 5, k0 = (v & 31) * 8; float f[8];
            if (n < 128) { const int pp = n & 63, s = k0 >> 4, c0 = k0 & 15; const float l_r = lamre[(15 - s) * 64 + pp], l_i = lamim[(15 - s) * 64 + pp];
#pragma unroll
                for (int j = 0; j < 8; ++j) { const float b_r = bbre[pp * 16 + c0 + j], b_i = bbim[pp * 16 + c0 + j]; f[j] = (n < 64) ? (l_r * b_r - l_i * b_i) : (l_r * b_i + l_i * b_r); }
            } else {
#pragma unroll
                for (int j = 0; j < 8; ++j) f[j] = 0.f;
            }
            u32x4 w; w.x = pk2(f[0], f[1]); w.y = pk2(f[2], f[3]); w.z = pk2(f[4], f[5]); w.w = pk2(f[6], f[7]);
            *(u32x4*)(wsm + (size_t)n * 256 + k0) = w;
        }
        __syncthreads();
    }
}

__device__ __forceinline__ void attn_qblock(const bf16x8 Bq0, const bf16x8 Bq1, const LAS bf16_t* Ksh, const LAS bf16_t* Vth, LAS float* ssrow, int kb0, int padblk, int fr, int fq, float sink,
                                            f32x4& o0, f32x4& o1, f32x4& o2, f32x4& o3) {
    bf16x8 Bq[2] = {Bq0, Bq1};
    f32x4 S[12];
#pragma unroll
    for (int kbk = 0; kbk < 12; ++kbk) {
        S[kbk] = (f32x4){0.f, 0.f, 0.f, 0.f};
        if (kbk >= kb0) {
#pragma unroll
            for (int kk = 0; kk < 2; ++kk) { const bf16x8 a = *(const LAS bf16x8*)(Ksh + (kbk * 16 + fr) * 72 + kk * 32 + fq * 8); S[kbk] = __builtin_amdgcn_mfma_f32_16x16x32_bf16(a, Bq[kk], S[kbk], 0, 0, 0); }
            if (kbk == padblk) S[kbk] = (f32x4){-3.0e38f, -3.0e38f, -3.0e38f, -3.0e38f};
        }
    }
    float mx = -3.0e38f;
#pragma unroll
    for (int kbk = 0; kbk < 12; ++kbk) if (kbk >= kb0) mx = fmaxf(mx, fmaxf(fmaxf(S[kbk][0], S[kbk][1]), fmaxf(S[kbk][2], S[kbk][3])));
    mx = fmaxf(mx, __shfl_xor(mx, 16)); mx = fmaxf(mx, __shfl_xor(mx, 32));
    const float mm = fmaxf(mx * 0.125f, sink); float sum = 0.f;
#pragma unroll
    for (int kbk = 0; kbk < 12; ++kbk) {
        if (kbk >= kb0) {
#pragma unroll
            for (int j = 0; j < 4; ++j) { const float e = __expf(S[kbk][j] * 0.125f - mm); S[kbk][j] = e; sum += e; }
        }
    }
    sum += __shfl_xor(sum, 16); sum += __shfl_xor(sum, 32);
    const float inv = 1.0f / (sum + __expf(sink - mm));
    f32x4 Ot[4];
#pragma unroll
    for (int db = 0; db < 4; ++db) Ot[db] = (f32x4){0.f, 0.f, 0.f, 0.f};
#pragma unroll
    for (int ks = 0; ks < 6; ++ks) {
        if (2 * ks >= kb0) {
            u32x4 pw; pw.x = pk2(S[2 * ks][0] * inv, S[2 * ks][1] * inv); pw.y = pk2(S[2 * ks][2] * inv, S[2 * ks][3] * inv);
            pw.z = pk2(S[2 * ks + 1][0] * inv, S[2 * ks + 1][1] * inv); pw.w = pk2(S[2 * ks + 1][2] * inv, S[2 * ks + 1][3] * inv);
            const bf16x8 pb = __builtin_bit_cast(bf16x8, pw);
#pragma unroll
            for (int db = 0; db < 4; ++db) {
                const LAS bf16_t* vp = Vth + (db * 16 + fr) * 200 + ks * 32 + fq * 4;
                const u32x2 lo = *(const LAS u32x2*)vp, hi = *(const LAS u32x2*)(vp + 16);
                u32x4 aw; aw.x = lo.x; aw.y = lo.y; aw.z = hi.x; aw.w = hi.y;
                Ot[db] = __builtin_amdgcn_mfma_f32_16x16x32_bf16(__builtin_bit_cast(bf16x8, aw), pb, Ot[db], 0, 0, 0);
            }
        }
    }
    float ssq = 0.f;
#pragma unroll
    for (int db = 0; db < 4; ++db) ssq += (Ot[db][0] * Ot[db][0] + Ot[db][1] * Ot[db][1]) + (Ot[db][2] * Ot[db][2] + Ot[db][3] * Ot[db][3]);
    ssq += __shfl_xor(ssq, 16); ssq += __shfl_xor(ssq, 32);
    if (fq == 0) *ssrow = ssq;
    o0 = Ot[0]; o1 = Ot[1]; o2 = Ot[2]; o3 = Ot[3];
}
__device__ __forceinline__ void attn_qstore(bf16_t* mrow, const LAS float* ssrow, const float* ga, int fq, const f32x4& o0, const f32x4& o1, const f32x4& o2, const f32x4& o3) {
    float tot = 0.f;
#pragma unroll
    for (int hh = 0; hh < 8; ++hh) tot += ssrow[hh];
    const float rstd = rsqrtf(tot * (1.0f / 512.0f) + EPS);
    *(u32x2*)(mrow + 0 * 16 + fq * 4) = pk4(o0 * rstd * ld4(ga + 0 * 16 + fq * 4));
    *(u32x2*)(mrow + 1 * 16 + fq * 4) = pk4(o1 * rstd * ld4(ga + 1 * 16 + fq * 4));
    *(u32x2*)(mrow + 2 * 16 + fq * 4) = pk4(o2 * rstd * ld4(ga + 2 * 16 + fq * 4));
    *(u32x2*)(mrow + 3 * 16 + fq * 4) = pk4(o3 * rstd * ld4(ga + 3 * 16 + fq * 4));
}

__device__ __forceinline__ void attn_prompt_item(LAS unsigned char* lds, const P& p, int item) {
    const unsigned char* ws = p.ws;
    const bf16_t* qb = (const bf16_t*)(ws + WS_Q); const bf16_t* kb = (const bf16_t*)(ws + WS_K); const bf16_t* vb = (const bf16_t*)(ws + WS_V);
    bf16_t* mrg = (bf16_t*)(p.ws + WS_MRG);
    const int tid = threadIdx.x, lane = tid & 63, h = __builtin_amdgcn_readfirstlane(tid >> 6), fr = lane & 15, fq = lane >> 4;
    const int b = item >> 7, n = item & 127;
    const int r0 = b * 8192 + n * 64;
    const int kb0 = n >= 2 ? 0 : (n == 1 ? 4 : 8);
    const int key0tok = r0 - 128;
    bf16x8 Q0a, Q0b, Q1a, Q1b, Q2a, Q2b, Q3a, Q3b;
    { const bf16_t* qrow0 = qb + (size_t)(r0 + fr) * 512 + h * 64 + fq * 8;
      Q0a = *(const bf16x8*)(qrow0); Q0b = *(const bf16x8*)(qrow0 + 32); Q1a = *(const bf16x8*)(qrow0 + 16 * 512); Q1b = *(const bf16x8*)(qrow0 + 16 * 512 + 32);
      Q2a = *(const bf16x8*)(qrow0 + 32 * 512); Q2b = *(const bf16x8*)(qrow0 + 32 * 512 + 32); Q3a = *(const bf16x8*)(qrow0 + 48 * 512); Q3b = *(const bf16x8*)(qrow0 + 48 * 512 + 32); }
    LAS bf16_t* Ks = (LAS bf16_t*)lds;
    LAS bf16_t* Vt = (LAS bf16_t*)(lds + 55296);
    LAS float* ss = (LAS float*)(lds + 55296 + 51200);
#pragma unroll
    for (int i = 0; i < 6; ++i) {
        const int idx = tid + i * NTHR; const int key = idx >> 4, pc = idx & 15;
        if (key >= kb0 * 16) { const u32x4 w = *(const u32x4*)(kb + (size_t)(key0tok + key) * 128 + pc * 8); *(LAS u32x4*)(Ks + ((pc >> 3) * 192 + key) * 72 + (pc & 7) * 8) = w; }
    }
#pragma unroll
    for (int i = 0; i < 6; ++i) {
        const int idx = tid + i * NTHR; const int key = idx % 192, pc = idx / 192;
        if (key >= kb0 * 16) {
            const u32x4 w = *(const u32x4*)(vb + (size_t)(key0tok + key) * 128 + pc * 8);
            LAS bf16_t* d = Vt + ((pc >> 3) * 64 + (pc & 7) * 8) * 200 + key;
            d[0] = (bf16_t)(w.x & 0xffff); d[200] = (bf16_t)(w.x >> 16); d[400] = (bf16_t)(w.y & 0xffff); d[600] = (bf16_t)(w.y >> 16);
            d[800] = (bf16_t)(w.z & 0xffff); d[1000] = (bf16_t)(w.z >> 16); d[1200] = (bf16_t)(w.w & 0xffff); d[1400] = (bf16_t)(w.w >> 16);
        }
    }
    __syncthreads();
    const int kvh = h >> 2;
    const float sink = p.sinks[h];
    const LAS bf16_t* Ksh = Ks + kvh * 192 * 72; const LAS bf16_t* Vth = Vt + kvh * 64 * 200;
    f32x4 a0, a1, a2, a3, b0, b1, b2, b3, c0, c1, c2, c3, d0, d1, d2, d3;
    attn_qblock(Q0a, Q0b, Ksh, Vth, ss + (0 * 16 + fr) * 8 + h, kb0, -1, fr, fq, sink, a0, a1, a2, a3);
    attn_qblock(Q1a, Q1b, Ksh, Vth, ss + (1 * 16 + fr) * 8 + h, kb0, -1, fr, fq, sink, b0, b1, b2, b3);
    attn_qblock(Q2a, Q2b, Ksh, Vth, ss + (2 * 16 + fr) * 8 + h, kb0, -1, fr, fq, sink, c0, c1, c2, c3);
    attn_qblock(Q3a, Q3b, Ksh, Vth, ss + (3 * 16 + fr) * 8 + h, kb0, -1, fr, fq, sink, d0, d1, d2, d3);
    __syncthreads();
    bf16_t* mrow = mrg + (size_t)(r0 + fr) * 1024 + h * 64; const float* ga = p.on_a + h * 64;
    attn_qstore(mrow, ss + (0 * 16 + fr) * 8, ga, fq, a0, a1, a2, a3);
    attn_qstore(mrow + 16 * 1024, ss + (1 * 16 + fr) * 8, ga, fq, b0, b1, b2, b3);
    attn_qstore(mrow + 32 * 1024, ss + (2 * 16 + fr) * 8, ga, fq, c0, c1, c2, c3);
    attn_qstore(mrow + 48 * 1024, ss + (3 * 16 + fr) * 8, ga, fq, d0, d1, d2, d3);
    __syncthreads();
}

__device__ __forceinline__ void attn_sample_item(LAS unsigned char* lds, const P& p, int b) {
    const unsigned char* ws = p.ws;
    const bf16_t* qb = (const bf16_t*)(ws + WS_Q); const bf16_t* kb = (const bf16_t*)(ws + WS_K); const bf16_t* vb = (const bf16_t*)(ws + WS_V);
    bf16_t* mrg = (bf16_t*)(p.ws + WS_MRG);
    const int tid = threadIdx.x, lane = tid & 63, h = __builtin_amdgcn_readfirstlane(tid >> 6), fr = lane & 15, fq = lane >> 4;
    const int r0 = NPR + b * 16;
    const bf16_t* qrow0 = qb + (size_t)(r0 + fr) * 512 + h * 64 + fq * 8;
    const bf16x8 Qa = *(const bf16x8*)(qrow0), Qb = *(const bf16x8*)(qrow0 + 32);
    LAS bf16_t* Ks = (LAS bf16_t*)lds;
    LAS bf16_t* Vt = (LAS bf16_t*)(lds + 55296);
    LAS float* ss = (LAS float*)(lds + 55296 + 51200);
#pragma unroll
    for (int i = 0; i < 4; ++i) {
        const int idx = tid + i * NTHR; const int key = idx >> 4, pc = idx & 15; const int kvh = pc >> 3, d0 = (pc & 7) * 8;
        const float* src = p.cache_k + ((size_t)(b * 128 + key) * 2 + kvh) * 64 + d0; const f32x4 x0 = ld4(src), x1 = ld4(src + 4);
        u32x4 w; w.x = pk2(x0[0], x0[1]); w.y = pk2(x0[2], x0[3]); w.z = pk2(x1[0], x1[1]); w.w = pk2(x1[2], x1[3]);
        *(LAS u32x4*)(Ks + (kvh * 192 + 48 + key) * 72 + d0) = w;
    }
    { const int t2 = tid & 255; const int key = t2 >> 4, pc = t2 & 15; const int kvh = pc >> 3, d0 = (pc & 7) * 8;
      u32x4 w = (u32x4){0u, 0u, 0u, 0u};
      if (tid < 256) w = *(const u32x4*)(kb + (size_t)(r0 + key) * 128 + pc * 8);
      *(LAS u32x4*)(Ks + (kvh * 192 + (tid < 256 ? 176 : 32) + key) * 72 + d0) = w; }
#pragma unroll
    for (int i = 0; i < 4; ++i) {
        const int idx = tid + i * NTHR; const int key = idx & 127, pc = idx >> 7; const int kvh = pc >> 3, d0 = (pc & 7) * 8;
        const float* src = p.cache_v + ((size_t)(b * 128 + key) * 2 + kvh) * 64 + d0; const f32x4 x0 = ld4(src), x1 = ld4(src + 4);
        const unsigned w0 = pk2(x0[0], x0[1]), w1 = pk2(x0[2], x0[3]), w2 = pk2(x1[0], x1[1]), w3 = pk2(x1[2], x1[3]);
        LAS bf16_t* d = Vt + (kvh * 64 + d0) * 200 + 48 + key;
        d[0] = (bf16_t)(w0 & 0xffff); d[200] = (bf16_t)(w0 >> 16); d[400] = (bf16_t)(w1 & 0xffff); d[600] = (bf16_t)(w1 >> 16);
        d[800] = (bf16_t)(w2 & 0xffff); d[1000] = (bf16_t)(w2 >> 16); d[1200] = (bf16_t)(w3 & 0xffff); d[1400] = (bf16_t)(w3 >> 16);
    }
    { const int t2 = tid & 255; const int key = t2 & 15, pc = t2 >> 4; const int kvh = pc >> 3, d0 = (pc & 7) * 8;
      u32x4 w = (u32x4){0u, 0u, 0u, 0u};
      if (tid < 256) w = *(const u32x4*)(vb + (size_t)(r0 + key) * 128 + pc * 8);
      LAS bf16_t* d = Vt + (kvh * 64 + d0) * 200 + (tid < 256 ? 176 : 32) + key;
      d[0] = (bf16_t)(w.x & 0xffff); d[200] = (bf16_t)(w.x >> 16); d[400] = (bf16_t)(w.y & 0xffff); d[600] = (bf16_t)(w.y >> 16);
      d[800] = (bf16_t)(w.z & 0xffff); d[1000] = (bf16_t)(w.z >> 16); d[1200] = (bf16_t)(w.w & 0xffff); d[1400] = (bf16_t)(w.w >> 16); }
    __syncthreads();
    const int kvh = h >> 2; const float sink = p.sinks[h];
    f32x4 a0, a1, a2, a3;
    attn_qblock(Qa, Qb, Ks + kvh * 192 * 72, Vt + kvh * 64 * 200, ss + fr * 8 + h, 2, 2, fr, fq, sink, a0, a1, a2, a3);
    __syncthreads();
    attn_qstore(mrg + (size_t)(r0 + fr) * 1024 + h * 64, ss + fr * 8, p.on_a + h * 64, fq, a0, a1, a2, a3);
    __syncthreads();
}

__device__ __forceinline__ void ssm_sample_task(const P& p, int task) {
    const unsigned char* ws = p.ws;
    const float* lamT = (const float*)(ws + WS_LAM); const float* bbar = (const float*)(ws + WS_BBAR); const float* us = (const float*)(ws + WS_US);
    bf16_t* z = (bf16_t*)(p.ws + WS_Z);
    const int lane = threadIdx.x & 63, b = task >> 7, g = (task >> 2) & 31, qd = task & 3, pp = lane;
    const float lr = lamT[(size_t)(g * 64 + pp) * 4], li = lamT[(size_t)(g * 64 + pp) * 4 + 1];
    float bbr[16], bbi[16], cr[4], ci[4];
#pragma unroll
    for (int c = 0; c < 16; ++c) { bbr[c] = bbar[((size_t)(g * 64 + pp) * 16 + c) * 2]; bbi[c] = bbar[((size_t)(g * 64 + pp) * 16 + c) * 2 + 1]; }
#pragma unroll
    for (int c = 0; c < 4; ++c) { cr[c] = p.C_re[g * 1024 + (qd * 4 + c) * 64 + pp]; ci[c] = p.C_im[g * 1024 + (qd * 4 + c) * 64 + pp]; }
    float hr = p.st_re[(size_t)(b * 32 + g) * 64 + pp], hi = p.st_im[(size_t)(b * 32 + g) * 64 + pp];
    const float dsk = (lane < 4) ? p.Dskip[g * 16 + qd * 4 + lane] : 0.f;
    for (int t = 0; t < 16; ++t) {
        const float* ur = us + (size_t)(b * 16 + t) * 512 + g * 16;
        const float ul = (lane < 16) ? ur[lane] : 0.f;
        float bur = 0.f, bui = 0.f;
#pragma unroll
        for (int c = 0; c < 16; ++c) { const float uc = __shfl(ul, c); bur += bbr[c] * uc; bui += bbi[c] * uc; }
        const float nr = lr * hr - li * hi + bur, ni = lr * hi + li * hr + bui; hr = nr; hi = ni;
        float yv = 0.f;
#pragma unroll
        for (int c = 0; c < 4; ++c) { const float v = wsum(cr[c] * hr - ci[c] * hi); yv = (lane == c) ? v : yv; }
        const float zz = gelu_tanh(yv + dsk * __shfl(ul, qd * 4 + (lane & 3)));
        const float zn = __shfl_down(zz, 1);
        if (lane < 4 && (lane & 1) == 0) *(unsigned*)(z + (size_t)(NPR + b * 16 + t) * 512 + g * 16 + qd * 4 + lane) = pk2(zz, zn);
    }
    if (qd == 0) { p.out[O_RS + (size_t)(b * 32 + g) * 64 + pp] = hr; p.out[O_IS + (size_t)(b * 32 + g) * 64 + pp] = hi; }
}

__device__ __forceinline__ void scan_task(LAS unsigned char* lds, const P& p, int task) {
    const float* __restrict__ lamT = (const float*)(p.ws + WS_LAM); const bf16_t* __restrict__ sb = (const bf16_t*)(p.ws + WS_SB);
    bf16_t* __restrict__ uh = (bf16_t*)(p.ws + WS_UH);
    LAS float* ex = (LAS float*)lds;
    const int lane = threadIdx.x & 63, seg = threadIdx.x >> 6, b = task >> 5, g = task & 31, pp = lane;
    const float lr = lamT[(size_t)(g * 64 + pp) * 4 + 2], li = lamT[(size_t)(g * 64 + pp) * 4 + 3];
    const size_t R0 = (size_t)g * 2048 + (size_t)b * 512 + (size_t)seg * 64;
    float er = 0.f, ei = 0.f;
    for (int c0 = 0; c0 < 64; c0 += 16) {
        float sr[16], si[16];
#pragma unroll
        for (int j = 0; j < 16; ++j) { sr[j] = bf2f(sb[(R0 + c0 + j) * 128 + pp]); si[j] = bf2f(sb[(R0 + c0 + j) * 128 + 64 + pp]); }
#pragma unroll
        for (int j = 0; j < 16; ++j) { const float nr = lr * er - li * ei + sr[j], ni = lr * ei + li * er + si[j]; er = nr; ei = ni; }
    }
    ex[(seg * 64 + pp) * 2] = er; ex[(seg * 64 + pp) * 2 + 1] = ei;
    float qr = lr, qi = li;
#pragma unroll
    for (int k = 0; k < 6; ++k) { const float nr = qr * qr - qi * qi, ni = 2.0f * qr * qi; qr = nr; qi = ni; }
    __syncthreads();
    float hr = 0.f, hi = 0.f;
    for (int s2 = 0; s2 < seg; ++s2) { const float xr = ex[(s2 * 64 + pp) * 2], xi = ex[(s2 * 64 + pp) * 2 + 1]; const float nr = qr * hr - qi * hi + xr, ni = qr * hi + qi * hr + xi; hr = nr; hi = ni; }
    for (int c0 = 0; c0 < 64; c0 += 16) {
        float sr[16], si[16];
#pragma unroll
        for (int j = 0; j < 16; ++j) { sr[j] = bf2f(sb[(R0 + c0 + j) * 128 + pp]); si[j] = bf2f(sb[(R0 + c0 + j) * 128 + 64 + pp]); }
#pragma unroll
        for (int j = 0; j < 16; ++j) {
            uh[(R0 + c0 + j) * 384 + 256 + pp] = (bf16_t)(pk2(hr, 0.f) & 0xffff); uh[(R0 + c0 + j) * 384 + 320 + pp] = (bf16_t)(pk2(hi, 0.f) & 0xffff);
            const float nr = lr * hr - li * hi + sr[j], ni = lr * hi + li * hr + si[j]; hr = nr; hi = ni;
        }
    }
    if (seg == 7) { p.out[O_RP + (size_t)(b * 32 + g) * 64 + pp] = hr; p.out[O_IP + (size_t)(b * 32 + g) * 64 + pp] = hi; }
    __syncthreads();
}

__device__ __forceinline__ void sgemm_tile(const bf16_t* __restrict__ A, int lda, const bf16_t* __restrict__ W, int ldb, int K, int rb, int n0, int n1, int fr, int fq, f32x4& acc0, f32x4& acc1) {
    const bf16_t* ap = A + (size_t)(rb * 16 + fr) * lda + fq * 8;
    const bf16_t* b0p = W + (size_t)(n0 + fr) * ldb + fq * 8;
    const bf16_t* b1p = W + (size_t)(n1 + fr) * ldb + fq * 8;
    f32x4 c0 = (f32x4){0.f, 0.f, 0.f, 0.f}, c1 = (f32x4){0.f, 0.f, 0.f, 0.f};
    int k0 = 0;
    for (; k0 + 256 <= K; k0 += 256) {
        bf16x8 a[8], b0[8], b1[8];
#pragma unroll
        for (int j = 0; j < 8; ++j) { a[j] = *(const bf16x8*)(ap + k0 + j * 32); b0[j] = *(const bf16x8*)(b0p + k0 + j * 32); b1[j] = *(const bf16x8*)(b1p + k0 + j * 32); }
#pragma unroll
        for (int j = 0; j < 8; ++j) { c0 = __builtin_amdgcn_mfma_f32_16x16x32_bf16(b0[j], a[j], c0, 0, 0, 0); c1 = __builtin_amdgcn_mfma_f32_16x16x32_bf16(b1[j], a[j], c1, 0, 0, 0); }
    }
    for (; k0 + 64 <= K; k0 += 64) {
        bf16x8 a[2], b0[2], b1[2];
#pragma unroll
        for (int j = 0; j < 2; ++j) { a[j] = *(const bf16x8*)(ap + k0 + j * 32); b0[j] = *(const bf16x8*)(b0p + k0 + j * 32); b1[j] = *(const bf16x8*)(b1p + k0 + j * 32); }
#pragma unroll
        for (int j = 0; j < 2; ++j) { c0 = __builtin_amdgcn_mfma_f32_16x16x32_bf16(b0[j], a[j], c0, 0, 0, 0); c1 = __builtin_amdgcn_mfma_f32_16x16x32_bf16(b1[j], a[j], c1, 0, 0, 0); }
    }
    acc0 = c0; acc1 = c1;
}
template <int SPLIT>
__device__ __forceinline__ bool sgemm_tile_ks(LAS float* red, const bf16_t* __restrict__ A, int lda, const bf16_t* __restrict__ W, int ldb, int K, int rb, int n0, int n1, int fr, int fq, int wave, bool valid, f32x4& acc0, f32x4& acc1) {
    const int kq = wave % SPLIT, Kq = K / SPLIT, lane = fq * 16 + fr;
    f32x4 c0 = (f32x4){0.f, 0.f, 0.f, 0.f}, c1 = c0;
    if (valid) sgemm_tile(A + kq * Kq, lda, W + kq * Kq, ldb, Kq, rb, n0, n1, fr, fq, c0, c1);
    if (kq != 0) { *(LAS f32x4*)(red + (wave * 64 + lane) * 8) = c0; *(LAS f32x4*)(red + (wave * 64 + lane) * 8 + 4) = c1; }
    __syncthreads();
    if (kq == 0) {
#pragma unroll
        for (int s2 = 1; s2 < SPLIT; ++s2) { c0 += *(const LAS f32x4*)(red + ((wave + s2) * 64 + lane) * 8); c1 += *(const LAS f32x4*)(red + ((wave + s2) * 64 + lane) * 8 + 4); }
    }
    __syncthreads();
    acc0 = c0; acc1 = c1;
    return kq == 0 && valid;
}

__device__ __forceinline__ void sample_in(LAS unsigned char* lds, const P& p) {
    unsigned char* ws = p.ws;
    const int lane = threadIdx.x & 63, wave = threadIdx.x >> 6, fr = lane & 15, fq = lane >> 4, G = gridDim.x;
    const bf16_t* A = (const bf16_t*)(ws + WS_XN1) + (size_t)NPR * 1024; const bf16_t* W = (const bf16_t*)(ws + WS_WIN);
    bf16_t* q = (bf16_t*)(ws + WS_Q); bf16_t* k = (bf16_t*)(ws + WS_K); bf16_t* v = (bf16_t*)(ws + WS_V); float* us = (float*)(ws + WS_US); const float* rope = (const float*)(ws + WS_ROPE);
    for (int it = blockIdx.x; it < 320; it += G) {
        const int t = it * 2 + (wave >> 2); const int rb = t & 15, ct = t >> 4; f32x4 x1, x2;
        if (!sgemm_tile_ks<4>((LAS float*)lds, A, 1024, W, 1024, 1024, rb, ct * 32, ct * 32 + 16, fr, fq, wave, true, x1, x2)) continue;
        const int rs_ = rb * 16 + fr, r = NPR + rs_, b = rb, sq = fr;
        if (ct < 20) {
            const int pos = 2048 + sq, dbase = 16 * (ct & 1) + 4 * fq;
            const f32x4 cs = ld4(rope + pos * 32 + dbase), sn = ld4(rope + 262144 + pos * 32 + dbase);
            const f32x4 o1 = x1 * cs - x2 * sn, o2 = x2 * cs + x1 * sn;
            if (ct < 16) { bf16_t* dst = q + (size_t)r * 512 + (ct >> 1) * 64 + dbase; *(u32x2*)dst = pk4(o1); *(u32x2*)(dst + 32) = pk4(o2); }
            else { const int cc = ((ct - 16) >> 1) * 64 + dbase; bf16_t* dst = k + (size_t)r * 128 + cc; *(u32x2*)dst = pk4(o1); *(u32x2*)(dst + 32) = pk4(o2);
                float* o = p.out + O_KS + ((size_t)(b * 128 + 112 + sq)) * 128 + cc; st4(o, o1); st4(o + 32, o2); }
        } else if (ct < 24) {
            const int cv = 32 * (ct - 20) + 4 * fq;
            *(u32x2*)(v + (size_t)r * 128 + cv) = pk4(x1); *(u32x2*)(v + (size_t)r * 128 + cv + 16) = pk4(x2);
            float* o = p.out + O_VS + ((size_t)(b * 128 + 112 + sq)) * 128 + cv; st4(o, x1); st4(o + 16, x2);
        } else {
            const int cu = 32 * (ct - 24) + 4 * fq; st4(us + (size_t)rs_ * 512 + cu, x1); st4(us + (size_t)rs_ * 512 + cu + 16, x2);
        }
    }
}
__device__ __forceinline__ void sample_glu(LAS unsigned char* lds, const P& p) {
    unsigned char* ws = p.ws;
    const int lane = threadIdx.x & 63, wave = threadIdx.x >> 6, fr = lane & 15, fq = lane >> 4, G = gridDim.x;
    const bf16_t* z = (const bf16_t*)(ws + WS_Z); bf16_t* mrg = (bf16_t*)(ws + WS_MRG); float* rss = (float*)(ws + WS_RSS_S);
    for (int it = blockIdx.x; it < 128; it += G) {
        const int t = it * 2 + (wave >> 2); const int rb = t & 15, ct = t >> 4; f32x4 a0, a1;
        if (!sgemm_tile_ks<4>((LAS float*)lds, z + (size_t)NPR * 512, 512, (const bf16_t*)(ws + WS_WGLU), 512, 512, rb, ct * 32, ct * 32 + 16, fr, fq, wave, true, a0, a1)) continue;
        const int r = NPR + rb * 16 + fr; float ssq = 0.f;
#pragma unroll
        for (int h = 0; h < 2; ++h) {
            const int col = ct * 32 + h * 16 + 4 * fq; const f32x4 a = h ? a1 : a0; const u32x2 zw = *(const u32x2*)(z + (size_t)r * 512 + col);
            f32x4 o; o[0] = bflo(zw.x) * sigmoidf(a[0]); o[1] = bfhi(zw.x) * sigmoidf(a[1]); o[2] = bflo(zw.y) * sigmoidf(a[2]); o[3] = bfhi(zw.y) * sigmoidf(a[3]);
            ssq += (o[0] * o[0] + o[1] * o[1]) + (o[2] * o[2] + o[3] * o[3]);
            *(u32x2*)(mrg + (size_t)r * 1024 + 512 + col) = pk4(o);
        }
        ssq += __shfl_xor(ssq, 16); ssq += __shfl_xor(ssq, 32);
        if (fq == 0) atomicAdd(rss + r, ssq);
    }
}
__device__ __forceinline__ void sample_out(LAS unsigned char* lds, const P& p) {
    unsigned char* ws = p.ws;
    const int lane = threadIdx.x & 63, wave = threadIdx.x >> 6, fr = lane & 15, fq = lane >> 4, G = gridDim.x;
    bf16_t* x1b = (bf16_t*)(ws + WS_X1B); float* rss = (float*)(ws + WS_RSS_2);
    for (int it = blockIdx.x; it < 256; it += G) {
        const int t = it * 2 + (wave >> 2); const int rb = t & 15, ct = t >> 4; f32x4 a0, a1, s0, s1;
        (void)sgemm_tile_ks<4>((LAS float*)lds, (const bf16_t*)(ws + WS_MRG) + (size_t)NPR * 1024, 1024, (const bf16_t*)(ws + WS_WOUT), 1024, 512, rb, ct * 32, ct * 32 + 16, fr, fq, wave, true, a0, a1);
        if (!sgemm_tile_ks<4>((LAS float*)lds, (const bf16_t*)(ws + WS_MRG) + (size_t)NPR * 1024 + 512, 1024, (const bf16_t*)(ws + WS_WOUT) + 512, 1024, 512, rb, ct * 32, ct * 32 + 16, fr, fq, wave, true, s0, s1)) continue;
        const int rs_ = rb * 16 + fr, r = NPR + rs_; float ssq = 0.f;
        { const float rstd_s = rsqrtf(((const float*)(ws + WS_RSS_S))[r] * (1.0f / 512.0f) + EPS); a0 += s0 * rstd_s; a1 += s1 * rstd_s; }
#pragma unroll
        for (int h = 0; h < 2; ++h) {
            const int col = ct * 32 + h * 16 + 4 * fq; const f32x4 o = ld4(p.x_sample + (size_t)rs_ * 1024 + col) + (h ? a1 : a0);
            ssq += (o[0] * o[0] + o[1] * o[1]) + (o[2] * o[2] + o[3] * o[3]);
            if (h) a1 = o; else a0 = o;
        }
        ssq += __shfl_xor(ssq, 16); ssq += __shfl_xor(ssq, 32);
        if (fq == 0) atomicAdd(rss + r, ssq);
        arrive_wait((unsigned*)(ws + WS_CNT) + (784 + rb) * 16, 32u);
        const float rstd = rsqrtf(ld_agent(rss + r) * (1.0f / 1024.0f) + EPS);
        { const int col = ct * 32 + 4 * fq; *(u32x2*)(x1b + (size_t)r * 1024 + col) = pk4(a0 * rstd); *(u32x2*)(x1b + (size_t)r * 1024 + col + 16) = pk4(a1 * rstd); }
    }
}
__device__ __forceinline__ void sample_up(LAS unsigned char* lds, const P& p) {
    unsigned char* ws = p.ws;
    const int lane = threadIdx.x & 63, wave = threadIdx.x >> 6, fr = lane & 15, fq = lane >> 4, G = gridDim.x;
    bf16_t* hb = (bf16_t*)(ws + WS_H); const float* rss2 = (const float*)(ws + WS_RSS_2); const float* cw = p.conv_w; const float* cb = p.conv_b; const float* sc = p.st_conv; float* ocs = p.out + O_CS;
#define DPPR(ctl, v) __int_as_float(__builtin_amdgcn_update_dpp(0, __float_as_int(v), (ctl), 0xF, 0xF, true))
    for (int it = blockIdx.x; it < 704; it += G) {
        const int t = it * 4 + (wave >> 1); const int rb = t & 15, ct = t >> 4; const int pn = ct >> 3, j = ct & 7; f32x4 xg, xv;
        const int r = NPR + rb * 16 + fr, b = rb;
        const int cg = pn * 128 + j * 16 + 4 * fq, cv = DFF + cg;
        f32x4 w0g, w1g, w2g, bg, w0v, w1v, w2v, bv, s0g, s1g, s0v, s1v;
        if ((wave & 1) == 0) {
            w0g = ld4(cw + cg); w1g = ld4(cw + DFF2 + cg); w2g = ld4(cw + 2 * DFF2 + cg); bg = ld4(cb + cg);
            w0v = ld4(cw + cv); w1v = ld4(cw + DFF2 + cv); w2v = ld4(cw + 2 * DFF2 + cv); bv = ld4(cb + cv);
            s0g = ld4(sc + (size_t)(b * 2) * DFF2 + cg); s1g = ld4(sc + (size_t)(b * 2 + 1) * DFF2 + cg);
            s0v = ld4(sc + (size_t)(b * 2) * DFF2 + cv); s1v = ld4(sc + (size_t)(b * 2 + 1) * DFF2 + cv);
        }
        if (!sgemm_tile_ks<2>((LAS float*)lds, (const bf16_t*)(ws + WS_X1B) + (size_t)NPR * 1024, 1024, (const bf16_t*)(ws + WS_WUP), 1024, 1024, rb, pn * 256 + j * 16, pn * 256 + 128 + j * 16, fr, fq, wave, true, xg, xv)) continue;
        f32x4 hv;
#pragma unroll
        for (int i = 0; i < 4; ++i) {
            float p1g = DPPR(0x121, xg[i]), p2g = DPPR(0x122, xg[i]), p1v = DPPR(0x121, xv[i]), p2v = DPPR(0x122, xv[i]);
            p1g = fr == 0 ? s1g[i] : p1g; p2g = fr == 0 ? s0g[i] : (fr == 1 ? s1g[i] : p2g);
            p1v = fr == 0 ? s1v[i] : p1v; p2v = fr == 0 ? s0v[i] : (fr == 1 ? s1v[i] : p2v);
            const float gate = w0g[i] * p2g + w1g[i] * p1g + w2g[i] * xg[i] + bg[i], val = w0v[i] * p2v + w1v[i] * p1v + w2v[i] * xv[i] + bv[i];
            hv[i] = gate * sigmoidf(gate) * val;
        }
        *(u32x2*)(hb + (size_t)r * DFF + cg) = pk4(hv);
        if (fr >= 14) { float* e = ocs + ((size_t)b * 2 + (fr - 14)) * DFF2; st4(e + cg, xg); st4(e + cv, xv); }
    }
#undef DPPR
}
__device__ __forceinline__ void sample_down(LAS unsigned char* lds, const P& p) {
    unsigned char* ws = p.ws;
    const int lane = threadIdx.x & 63, wave = threadIdx.x >> 6, fr = lane & 15, fq = lane >> 4, G = gridDim.x;
    const bf16_t* x1b = (const bf16_t*)(ws + WS_X1B); float* rss = (float*)(ws + WS_RSS_3);
    for (int it = blockIdx.x; it < 256; it += G) {
        const int t = it * 2 + (wave >> 2); const int rb = t & 15, ct = t >> 4; f32x4 a0, a1;
        if (!sgemm_tile_ks<4>((LAS float*)lds, (const bf16_t*)(ws + WS_H) + (size_t)NPR * DFF, DFF, (const bf16_t*)(ws + WS_WDOWN), DFF, DFF, rb, ct * 32, ct * 32 + 16, fr, fq, wave, true, a0, a1)) continue;
        const int r = NPR + rb * 16 + fr; float ssq = 0.f;
#pragma unroll
        for (int h = 0; h < 2; ++h) {
            const int col = ct * 32 + h * 16 + 4 * fq; const u32x2 xw = *(const u32x2*)(x1b + (size_t)r * 1024 + col); f32x4 o = h ? a1 : a0;
            const float inv2 = sqrtf(((const float*)(ws + WS_RSS_2))[r] * (1.0f / 1024.0f) + EPS);
            o[0] += bflo(xw.x) * inv2; o[1] += bfhi(xw.x) * inv2; o[2] += bflo(xw.y) * inv2; o[3] += bfhi(xw.y) * inv2;
            ssq += (o[0] * o[0] + o[1] * o[1]) + (o[2] * o[2] + o[3] * o[3]);
            if (h) a1 = o; else a0 = o;
        }
        ssq += __shfl_xor(ssq, 16); ssq += __shfl_xor(ssq, 32);
        if (fq == 0) atomicAdd(rss + r, ssq);
        arrive_wait((unsigned*)(ws + WS_CNT) + (512 + rb) * 16, 32u);
        const float rstd = rsqrtf(ld_agent(rss + r) * (1.0f / 1024.0f) + EPS);
        { const int col = ct * 32 + 4 * fq; st4(p.out + (size_t)r * 1024 + col, a0 * rstd * ld4(p.final_g + col)); st4(p.out + (size_t)r * 1024 + col + 16, a1 * rstd * ld4(p.final_g + col + 16)); }
    }
}

__global__ void __launch_bounds__(NTHR) mega(P p) {
    extern __shared__ __attribute__((aligned(16))) unsigned char lds_raw[];
    LAS unsigned char* lds = (LAS unsigned char*)lds_raw;
    cg::grid_group grid = cg::this_grid();
    unsigned char* ws = p.ws;
    const int G = gridDim.x, blk = blockIdx.x, tid = threadIdx.x, lane = tid & 63, wave = tid >> 6;
    const int lo = p.ph_lo, hi = p.ph_hi;
#ifndef PHM
#define PHM 0xFFF
#endif
#define IN(k) (((PHM >> (k)) & 1) && lo <= (k) && (k) < hi)
    if (tid < 4) ((LAS unsigned*)(lds + 131072))[tid] = 0u;
    __syncthreads();
    (void)xcd_barrier_post((unsigned*)(ws + WS_BAR), (volatile LAS unsigned*)(lds + 131072));
#define SEAM(k) do { if (IN(k) && ((k) == 5 ? IN(7) : (k) == 8 ? IN(10) : IN((k) + 1))) { if (p.ph_lo < 0) grid.sync(); else { XcdBarrier xb_; xb_.bar = (unsigned*)(p.ws + WS_BAR); xb_.x = xb_xcc_id(); xb_.st = (volatile LAS unsigned*)(lds + 131072); xcd_barrier(xb_); } } } while (0)

    if (IN(0)) phase0(lds, p);
    SEAM(0);
    if (IN(1)) {
        pg8::Gemm g{(const bf16_t*)(ws + WS_XN1), (const bf16_t*)(ws + WS_WIN), 1024, 1024, 1024}; pg8::StaticOrder S; S.init(NPR, 1280, G, blk);
        sample_in(lds, p);
        EpiIn E{(bf16_t*)(ws + WS_Q), (bf16_t*)(ws + WS_K), (bf16_t*)(ws + WS_V), (bf16_t*)(ws + WS_UH), (float*)(ws + WS_US), (const float*)(ws + WS_ROPE), p.out};
        pg8::gemm_phase(lds, g, S, E);
        if (blk >= G / 2) { __syncthreads(); p0_tr_range(lds, p, 320 + (blk - G / 2), G - G / 2, 2048); }
    }
    SEAM(1);
    if (IN(2)) {
        { pg8::Gemm g{(const bf16_t*)(ws + WS_UH), (const bf16_t*)(ws + WS_WS), 384, 256, 256}; pg8::GroupOrder S{G, blk}; EpiS E{(bf16_t*)(ws + WS_SB)}; pg8::gemm_phase(lds, g, S, E); }
        __syncthreads();
        for (int task = blk * 8 + wave; task < 2048; task += 8 * G) ssm_sample_task(p, task);
        __syncthreads();
        for (int it0 = blk; it0 < 512; it0 += G) attn_prompt_item(lds, p, ((it0 & 7) << 6) | (it0 >> 3));
        for (int item = blk; item < 16; item += G) attn_sample_item(lds, p, item);
    }
    SEAM(2);
    if (IN(3)) { for (int task = blk; task < 128; task += G) scan_task(lds, p, task);
        if (blk >= G / 2) { __syncthreads(); p0_tr_range(lds, p, 2048 + (blk - G / 2), G - G / 2, 2752); } }
    SEAM(3);
    if (IN(4)) {
        pg8::Gemm g{(const bf16_t*)(ws + WS_UH), (const bf16_t*)(ws + WS_WY), 384, 384, 384}; pg8::GroupOrder S{G, blk}; EpiY E{(bf16_t*)(ws + WS_Z)}; pg8::gemm_phase<EpiY, pg8::GroupOrder, false, true>(lds, g, S, E);
    }
    SEAM(4);
    if (IN(5)) {
        pg8::Gemm g{(const bf16_t*)(ws + WS_Z), (const bf16_t*)(ws + WS_WGLU), 512, 512, 512}; pg8::StaticOrder S; S.init(NPR, 512, G, blk);
        sample_glu(lds, p);
        EpiGlu E{(const bf16_t*)(ws + WS_Z), (bf16_t*)(ws + WS_MRG), (float*)(ws + WS_RSS_S), (unsigned*)(ws + WS_CNT)}; pg8::gemm_phase<EpiGlu, pg8::StaticOrder, false, true>(lds, g, S, E);
    }
    SEAM(5);
    if (IN(7)) {
        pg8::Gemm g{(const bf16_t*)(ws + WS_MRG), (const bf16_t*)(ws + WS_WOUT), 1024, 1024, 1024}; pg8::StaticOrder S; S.init(NPR, 1024, G, blk);
        sample_out(lds, p);
        EpiOut E{p.x_prompt, p.x_sample, (bf16_t*)(ws + WS_X1B), (float*)(ws + WS_RSS_2), (unsigned*)(ws + WS_CNT)}; pg8::gemm_phase<EpiOut, pg8::StaticOrder, false, true>(lds, g, S, E);
    }
    SEAM(7);
    if (IN(8)) {
        pg8::Gemm g{(const bf16_t*)(ws + WS_X1B), (const bf16_t*)(ws + WS_WUP), 1024, 1024, 1024}; pg8::StaticOrder S; S.init(NPR, DFF2, G, blk);
        sample_up(lds, p);
        EpiUp E{p.conv_w, p.conv_b, (bf16_t*)(ws + WS_H), (float*)(ws + WS_EB)}; pg8::gemm_phase<EpiUp, pg8::StaticOrder, true, true>(lds, g, S, E);
    }
    SEAM(8);
    if (IN(10)) {
        pg8::Gemm g{(const bf16_t*)(ws + WS_H), (const bf16_t*)(ws + WS_WDOWN), DFF, DFF, DFF}; pg8::StaticOrder S; S.init(NPR, 1024, G, blk);
        sample_down(lds, p);
        {
            const float* eb = (const float*)(ws + WS_EB); bf16_t* hb = (bf16_t*)(ws + WS_H);
            pg8::Unit uu;
            for (int i = 0; S.next(i, uu); ++i) {
                for (int e = tid; e < 4 * DFF; e += NTHR) {
                    const int j = uu.pm * 4 + e / DFF, c = e % DFF;
                    const float* ee = eb + (size_t)j * 4 * DFF2;
                    const float e0g = ee[c], e0v = ee[DFF + c], e1g = ee[DFF2 + c], e1v = ee[DFF2 + DFF + c];
                    float p2g = 0.f, p2v = 0.f, p3g = 0.f, p3v = 0.f;
                    if (j & 127) { const float* q = ee - 2 * DFF2; p2g = q[c]; p2v = q[DFF + c]; p3g = q[DFF2 + c]; p3v = q[DFF2 + DFF + c]; }
                    const float w0g = p.conv_w[c], w1g = p.conv_w[DFF2 + c], w2g = p.conv_w[2 * DFF2 + c], bg = p.conv_b[c];
                    const float w0v = p.conv_w[DFF + c], w1v = p.conv_w[DFF2 + DFF + c], w2v = p.conv_w[2 * DFF2 + DFF + c], bv = p.conv_b[DFF + c];
                    const float g0 = w0g * p2g + w1g * p3g + w2g * e0g + bg, v0 = w0v * p2v + w1v * p3v + w2v * e0v + bv;
                    const float g1 = w0g * p3g + w1g * e0g + w2g * e1g + bg, v1 = w0v * p3v + w1v * e0v + w2v * e1v + bv;
                    hb[(size_t)(64 * j) * DFF + c] = (bf16_t)(pk2(g0 * sigmoidf(g0) * v0, 0.f) & 0xffff);
                    hb[(size_t)(64 * j + 1) * DFF + c] = (bf16_t)(pk2(g1 * sigmoidf(g1) * v1, 0.f) & 0xffff);
                }
            }
            for (size_t i = (size_t)blk * NTHR + tid; i < (size_t)4 * 2 * DFF2; i += (size_t)G * NTHR) {
                const int b = (int)(i / (2 * DFF2)), rem = (int)(i % (2 * DFF2)); const int sx = rem / DFF2, c = rem % DFF2;
                p.out[O_CP + i] = eb[((size_t)(128 * b + 127) * 4 + 2 + sx) * DFF2 + c];
            }
            asm volatile("s_waitcnt vmcnt(0)" ::: "memory");
            __syncthreads();
        }
        EpiDown E{(const bf16_t*)(ws + WS_X1B), p.out, (float*)(ws + WS_RSS_3), (unsigned*)(ws + WS_CNT), p.final_g, (const float*)(ws + WS_RSS_2)}; pg8::gemm_phase(lds, g, S, E);
    }
#undef IN
#undef SEAM
}

constexpr int NPHASE = 12;
#ifndef MK_PER_PHASE
#define MK_PER_PHASE 0
#endif

extern "C" void kernel_launch(void* const* d_in, const int* in_sizes, int n_in, void* d_out, int out_size, void* d_ws, size_t ws_size, hipStream_t stream) {
    static int grid = 0;
    if (grid == 0) {
        if (n_in != 28 || ws_size < WS_END) { fprintf(stderr, "kernel_launch: need 28 inputs and >= %zu bytes of workspace (got %d, %zu)\n", (size_t)WS_END, n_in, ws_size); grid = -1; return; }
        int dev = 0, cus = 0, per_cu = 0;
        hipGetDevice(&dev); hipDeviceGetAttribute(&cus, hipDeviceAttributeMultiprocessorCount, dev);
        if (hipFuncSetAttribute((const void*)mega, hipFuncAttributeMaxDynamicSharedMemorySize, LDS_BYTES) != hipSuccess) { fprintf(stderr, "kernel_launch: hipFuncSetAttribute failed\n"); grid = -1; return; }
        if (hipOccupancyMaxActiveBlocksPerMultiprocessor(&per_cu, (const void*)mega, NTHR, LDS_BYTES) != hipSuccess || per_cu < 1) { fprintf(stderr, "kernel_launch: occupancy query gave %d\n", per_cu); per_cu = 1; }
        (void)hipGetLastError();
        grid = cus * per_cu;
    }
    if (grid < 0) return;
    P p{};
    const float** pp = (const float**)&p;
    for (int i = 0; i < 28; ++i) pp[i] = (const float*)d_in[i];
    p.out = (float*)d_out; p.ws = (unsigned char*)d_ws;
#if MK_PER_PHASE
    for (int ph = 0; ph < NPHASE; ++ph) { p.ph_lo = ph; p.ph_hi = ph + 1; hipLaunchKernelGGL(mega, dim3(grid), dim3(NTHR), LDS_BYTES, stream, p); }
#else
    p.ph_lo = 0; p.ph_hi = NPHASE;
    if (hipMemsetAsync(d_ws, 0, (size_t)XCD_BAR_WORDS * 4, stream) != hipSuccess) { fprintf(stderr, "kernel_launch: memset of the barrier words failed\n"); return; }
    void* args[] = {&p};
    hipError_t e = hipLaunchCooperativeKernel((const void*)mega, dim3(grid), dim3(NTHR), args, LDS_BYTES, stream);
    if (e != hipSuccess) fprintf(stderr, "kernel_launch: cooperative launch failed: %s (grid %d)\n", hipGetErrorString(e), grid);
#endif
}
```

```cpp
#include <hip/hip_runtime.h>
#include <hip/hip_cooperative_groups.h>
#include <cstdio>
namespace cg = cooperative_groups;

#define LAS __attribute__((address_space(3)))
typedef unsigned short bf16_t;
typedef short bf16x8 __attribute__((ext_vector_type(8)));
typedef float f32x4 __attribute__((ext_vector_type(4)));
typedef unsigned u32x4 __attribute__((ext_vector_type(4)));
typedef unsigned u32x2 __attribute__((ext_vector_type(2)));

constexpr int DM = 1024, NPR = 32768, NSR = 256, MR = NPR + NSR, SEQ = 8192;
constexpr int DFF = 2816, DFF2 = 5632, NG = 32;
constexpr float EPS = 1e-6f;
constexpr int NTHR = 512;
constexpr int LDS_BYTES = 131072 + 16;

constexpr size_t al(size_t x) { return (x + 255) & ~(size_t)255; }
constexpr size_t WS_BAR = 0;
constexpr size_t WS_RSS_S = al((size_t)3456 * 4);
constexpr size_t WS_RSS_2 = WS_RSS_S + al((size_t)MR * 4);
constexpr size_t WS_RSS_3 = WS_RSS_2 + al((size_t)MR * 4);
constexpr size_t WS_CNT = WS_RSS_3 + al((size_t)MR * 4);
constexpr size_t WS_ROPE = WS_CNT + al((size_t)800 * 64);
constexpr size_t WS_LAM = WS_ROPE + al((size_t)8192 * 32 * 2 * 4);
constexpr size_t WS_BBAR = WS_LAM + al((size_t)32 * 64 * 4 * 4);
constexpr size_t WS_WIN = WS_BBAR + al((size_t)32 * 64 * 16 * 2 * 4);
constexpr size_t WS_WGLU = WS_WIN + al((size_t)1280 * 1024 * 2);
constexpr size_t WS_WOUT = WS_WGLU + al((size_t)512 * 512 * 2);
constexpr size_t WS_WUP = WS_WOUT + al((size_t)1024 * 1024 * 2);
constexpr size_t WS_WDOWN = WS_WUP + al((size_t)5632 * 1024 * 2);
constexpr size_t WS_WS = WS_WDOWN + al((size_t)1024 * 2816 * 2);
constexpr size_t WS_WY = WS_WS + al((size_t)32 * 256 * 256 * 2);
constexpr size_t WS_US = WS_WY + al((size_t)32 * 256 * 384 * 2);
constexpr size_t WS_X1B = WS_US + al((size_t)256 * 512 * 4);
constexpr size_t WS_R0 = WS_X1B + al((size_t)MR * 1024 * 2);
constexpr size_t WS_XN1 = WS_R0;
constexpr size_t WS_Q = WS_XN1 + al((size_t)MR * 1024 * 2);
constexpr size_t WS_K = WS_Q + al((size_t)MR * 512 * 2);
constexpr size_t WS_V = WS_K + al((size_t)MR * 128 * 2);
constexpr size_t WS_UH = WS_V + al((size_t)MR * 128 * 2);
constexpr size_t WS_SB = WS_UH + al((size_t)32 * 2048 * 384 * 2);
constexpr size_t WS_Z = WS_SB + al((size_t)32 * 2048 * 128 * 4);
constexpr size_t WS_MRG = WS_Z + al((size_t)MR * 512 * 2);
constexpr size_t WS_END1 = WS_MRG + al((size_t)MR * 1024 * 2);
constexpr size_t WS_H = WS_R0;
constexpr size_t WS_EB = WS_H + al((size_t)MR * 2816 * 2);
constexpr size_t WS_END2 = WS_EB + al((size_t)512 * 4 * 5632 * 4);
constexpr size_t WS_END = WS_END1 > WS_END2 ? WS_END1 : WS_END2;

constexpr size_t O_YP = 0, O_YS = 33554432, O_KP = O_YS + 262144, O_VP = O_KP + 65536, O_RP = O_VP + 65536, O_IP = O_RP + 8192,
                 O_CP = O_IP + 8192, O_KS = O_CP + 45056, O_VS = O_KS + 262144, O_RS = O_VS + 262144, O_IS = O_RS + 32768, O_CS = O_IS + 32768;

struct P {
    const float *x_prompt, *x_sample, *cache_k, *cache_v, *st_re, *st_im, *st_conv, *norm1_g, *w_in, *sinks, *A_re, *A_im, *log_dt, *B_re, *B_im,
        *C_re, *C_im, *Dskip, *w_glu, *on_a, *on_s, *w_out, *norm2_g, *w_up, *conv_w, *conv_b, *w_down, *final_g;
    float* out; unsigned char* ws; int ph_lo, ph_hi;
};

__device__ __forceinline__ unsigned pk2(float lo, float hi) { unsigned r; asm volatile("v_cvt_pk_bf16_f32 %0, %1, %2" : "=v"(r) : "v"(lo), "v"(hi)); return r; }
__device__ __forceinline__ float bf2f(bf16_t b) { return __uint_as_float(((unsigned)b) << 16); }
__device__ __forceinline__ float bflo(unsigned w) { return __uint_as_float(w << 16); }
__device__ __forceinline__ float bfhi(unsigned w) { return __uint_as_float(w & 0xffff0000u); }
__device__ __forceinline__ u32x2 pk4(f32x4 v) { u32x2 w; w.x = pk2(v[0], v[1]); w.y = pk2(v[2], v[3]); return w; }
__device__ __forceinline__ f32x4 ld4(const float* p) { return *(const f32x4*)p; }
__device__ __forceinline__ void st4(float* p, f32x4 v) { *(f32x4*)p = v; }
__device__ __forceinline__ float wsum(float v) { for (int o = 32; o >= 1; o >>= 1) v += __shfl_xor(v, o); return v; }
__device__ __forceinline__ float wmax(float v) { for (int o = 32; o >= 1; o >>= 1) v = fmaxf(v, __shfl_xor(v, o)); return v; }
__device__ __forceinline__ float gelu_tanh(float y) { const float u = 0.7978845608028654f * (y + 0.044715f * y * y * y); return y * __builtin_amdgcn_rcpf(1.0f + __expf(-2.0f * u)); }
__device__ __forceinline__ float sigmoidf(float x) { return __builtin_amdgcn_rcpf(1.0f + __expf(-x)); }

#define XB_TMO      128
#define XB_XCNT(j)  (256  + 64 * (j))
#define XB_XSUB(j)  (1280 + 64 * (j))
#define XB_XGEN(j)  (2304 + 64 * (j))
#define XB_TOP      3328
#define XB_TOPGEN   3392
#define XCD_BAR_WORDS 3456
#define XB_SPIN_CAP (1u << 18)
__device__ __forceinline__ unsigned xb_ld(unsigned* p)              { return __hip_atomic_load(p, __ATOMIC_RELAXED, __HIP_MEMORY_SCOPE_AGENT); }
__device__ __forceinline__ unsigned xb_add(unsigned* p, unsigned v) { return __hip_atomic_fetch_add(p, v, __ATOMIC_RELAXED, __HIP_MEMORY_SCOPE_AGENT); }
__device__ __forceinline__ unsigned xb_xcc_id() { return (unsigned)__builtin_amdgcn_s_getreg((3 << 11) | 20) & 0xFu; }
#define XB_SPIN(cond, bar) do { unsigned _sp = 0; while (cond) { __builtin_amdgcn_s_sleep(1); \
    if ((++_sp & 255u) == 0u) { if (xb_ld(&(bar)[XB_TMO])) break; if (_sp > XB_SPIN_CAP) { atomicAdd(&(bar)[XB_TMO], 1u); break; } } } } while (0)
struct XcdBarrier { unsigned* bar; unsigned x; volatile LAS unsigned* st; };
__device__ __forceinline__ XcdBarrier xcd_barrier_post(unsigned* bar, volatile LAS unsigned* st) {
    XcdBarrier b; b.bar = bar; b.x = xb_xcc_id(); b.st = st;
    if (threadIdx.x == 0) (void)xb_add(&bar[XB_XCNT(b.x)], 1u);
    return b;
}
__device__ __forceinline__ void xcd_barrier_complete(unsigned* bar, unsigned x, unsigned& nloc, unsigned& nx) {
    const unsigned G = gridDim.x * gridDim.y * gridDim.z;
    unsigned sum, cnt, mine, sp = 0u;
    for (;;) {
        sum = 0u; cnt = 0u; mine = 0u;
#pragma unroll
        for (unsigned j = 0; j < 16; ++j) { const unsigned c = xb_ld(&bar[XB_XCNT(j)]); sum += c; cnt += (c > 0u) ? 1u : 0u; mine = (j == x) ? c : mine; }
        if (sum == G) break;
        __builtin_amdgcn_s_sleep(1);
        if ((++sp & 255u) == 0u) { if (xb_ld(&bar[XB_TMO])) break; if (sp > XB_SPIN_CAP) { atomicAdd(&bar[XB_TMO], 1u); break; } }
    }
    nloc = mine > 0u ? mine : 1u; nx = cnt > 0u ? cnt : 1u;
}
__device__ __forceinline__ void xcd_barrier(const XcdBarrier& b) {
    asm volatile("s_waitcnt vmcnt(0)" ::: "memory");
    __syncthreads();
    if (threadIdx.x == 0) {
        unsigned* bar = b.bar;
        __builtin_amdgcn_s_waitcnt(0);
        unsigned nloc = b.st[0], nx = b.st[1];
        if (nloc == 0u) { xcd_barrier_complete(bar, b.x, nloc, nx); b.st[0] = nloc; b.st[1] = nx; }
        const unsigned old = xb_add(&bar[XB_XSUB(b.x)], 1u);
        const unsigned gen = old / nloc;
        if (old + 1u == (gen + 1u) * nloc) {
            __builtin_amdgcn_fence(__ATOMIC_RELEASE, "agent");
            asm volatile("s_waitcnt vmcnt(0)" ::: "memory");
            const unsigned og = xb_add(&bar[XB_TOP], 1u);
            const unsigned tg = og / nx;
            if (og + 1u == (tg + 1u) * nx) xb_add(&bar[XB_TOPGEN], 1u);
            else XB_SPIN(xb_ld(&bar[XB_TOPGEN]) == tg, bar);
            __builtin_amdgcn_fence(__ATOMIC_ACQUIRE, "agent");
            xb_add(&bar[XB_XGEN(b.x)], 1u);
            asm volatile("s_waitcnt vmcnt(0)" ::: "memory");
        } else {
            XB_SPIN(xb_ld(&bar[XB_XGEN(b.x)]) == gen, bar);
            __builtin_amdgcn_fence(__ATOMIC_ACQUIRE, "agent");
            asm volatile("s_waitcnt vmcnt(0)" ::: "memory");
        }
    }
    __syncthreads();
}

namespace pg8 {
constexpr int BM = 256, BK = 64, HALF = 128, HTB = HALF * BK * 2, NXCD = 8, WGM = 8;
__device__ __forceinline__ int lds_byte(int r, int c) { const int st = (r >> 4) * 2 + (c >> 5), rr = r & 15, cc = c & 31, ob = rr * 64 + cc * 2; return st * 1024 + (ob ^ (((ob >> 9) & 1) << 5)); }
__device__ __forceinline__ void stage_rc(int b, int& R, int& C) { const int st = b / 1024, sb = b % 1024, swz = sb ^ (((sb >> 9) & 1) << 5); R = (st >> 1) * 16 + swz / 64; C = (st & 1) * 32 + (swz % 64) / 2; }
struct Unit { int pm, pn; };
struct Gemm { const bf16_t* A; const bf16_t* Bt; int lda, ldb, K; };
struct StaticOrder {
    int nM, nN, nwg, G, c;
    __device__ __forceinline__ void init(int M, int N, int G_, int c_) { nM = M / BM; nN = N / BM; nwg = nM * nN; G = G_; c = c_; }
    __device__ __forceinline__ bool next(int i, Unit& u) const {
        const long L = (long)i * G + c; if (L >= nwg) return false;
        int wgid = (int)L; { const int q = nwg / NXCD, r = nwg % NXCD, xcd = wgid % NXCD, off = wgid / NXCD; wgid = (xcd < r ? xcd * (q + 1) : r * (q + 1) + (xcd - r) * q) + off; }
        const int nig = WGM * nN, gid = wgid / nig, fm = gid * WGM, gsz = (nM - fm) < WGM ? (nM - fm) : WGM;
        u.pm = fm + ((wgid % nig) % gsz); u.pn = (wgid % nig) / gsz; return true;
    }
};
struct GroupOrder {
    int G, c;
    __device__ __forceinline__ bool next(int i, Unit& u) const { const int L0 = i * G + c; if (L0 >= 256) return false; const int L = (G == 256) ? ((L0 & 7) * 32 + (L0 >> 3)) : L0; u.pm = L; u.pn = L >> 3; return true; }
};

__device__ __forceinline__ int perm32(int rho) { const int n = rho >> 4, i = rho & 15; return 8 * (i >> 2) + 4 * n + (i & 3); }
template <class Epi, class Sched, bool ROWPERM = false, bool PERMB = false>
__device__ __forceinline__ void gemm_phase(LAS unsigned char* lds, const Gemm g, const Sched& S, const Epi& E) {
    const int tid = threadIdx.x, wid = __builtin_amdgcn_readfirstlane(tid >> 6), lane = tid & 63, wr = wid >> 2, wc = wid & 3, fr = lane & 15, fq = lane >> 4;
    const int K = g.K, nt = K / BK;
    unsigned voffA[2], voffB[2];
#pragma unroll
    for (int i = 0; i < 2; ++i) { int R, C; stage_rc(tid * 16 + i * 8192, R, C); const int Ra = ROWPERM ? ((R & ~63) | ((R & 15) << 2) | ((R >> 4) & 3)) : R; const int Rb = PERMB ? ((R & ~31) + perm32(R & 31)) : R; voffA[i] = (unsigned)(Ra * g.lda + C) * 2u; voffB[i] = (unsigned)(Rb * g.ldb + C) * 2u; }
    const size_t kstep = (size_t)(BK * 2);
    const size_t hstepA = (size_t)HALF * g.lda * 2, hstepB = (size_t)HALF * g.ldb * 2;
    const size_t tstepA = 2 * hstepA, tstepB = 2 * hstepB;
    const unsigned ldsw = (unsigned)wid * 1024u;
    const int aoff = lds_byte(wr * 64 + fr, fq * 8), boff = lds_byte(wc * 32 + fr, fq * 8);
#define PG8_SA(b, h) (((b) * 2 + (h)) * HTB)
#define PG8_SB(b, h) ((4 + (b) * 2 + (h)) * HTB)
#define PG8_STAGE(bufoff, gbase, voff) do { _Pragma("unroll") for (int _i = 0; _i < 2; ++_i) \
        __builtin_amdgcn_global_load_lds((const unsigned*)((const char*)(gbase) + (voff)[_i]), (LAS unsigned*)(lds + (bufoff) + ldsw + _i * 8192), 16, 0, 0); } while (0)
#define PG8_LDA(dst, b, h) do { _Pragma("unroll") for (int m = 0; m < 4; ++m) _Pragma("unroll") for (int k = 0; k < 2; ++k) dst[m][k] = *(const LAS bf16x8*)(lds + PG8_SA(b, h) + aoff + m * 2048 + k * 1024); } while (0)
#define PG8_LDB(dst, b, h) do { _Pragma("unroll") for (int n = 0; n < 2; ++n) _Pragma("unroll") for (int k = 0; k < 2; ++k) dst[n][k] = *(const LAS bf16x8*)(lds + PG8_SB(b, h) + boff + n * 2048 + k * 1024); } while (0)
#define PG8_MMA(ai, bj, At, Bt) do { __builtin_amdgcn_s_setprio(1); _Pragma("unroll") for (int m = 0; m < 4; ++m) _Pragma("unroll") for (int n = 0; n < 2; ++n) _Pragma("unroll") for (int k = 0; k < 2; ++k) \
        acc[ai][bj][m][n] = __builtin_amdgcn_mfma_f32_16x16x32_bf16(Bt[n][k], At[m][k], acc[ai][bj][m][n], 0, 0, 0); __builtin_amdgcn_s_setprio(0); } while (0)
#define PG8_WAIT_V(n) asm volatile("s_waitcnt vmcnt(" #n ")" ::: "memory")
#define PG8_WAIT_L(n) asm volatile("s_waitcnt lgkmcnt(" #n ")" ::: "memory")
#define PG8_BAR __builtin_amdgcn_s_barrier()
#define PG8_SCHED __builtin_amdgcn_sched_barrier(0)
    Unit cur, nxt; int ui = 0;
    if (!S.next(0, cur)) return;
    f32x4 acc[2][2][4][2];
#pragma unroll
    for (int a = 0; a < 2; ++a)
#pragma unroll
        for (int b = 0; b < 2; ++b)
#pragma unroll
            for (int m = 0; m < 4; ++m)
#pragma unroll
                for (int n = 0; n < 2; ++n) acc[a][b][m][n] = (f32x4){0.f, 0.f, 0.f, 0.f};
    bf16x8 At[4][2], B0[2][2], B1[2][2];
    const char* cA = (const char*)g.A + (size_t)cur.pm * tstepA; const char* cB = (const char*)g.Bt + (size_t)cur.pn * tstepB;
    PG8_STAGE(PG8_SB(0, 0), cB, voffB); PG8_STAGE(PG8_SA(0, 0), cA, voffA); PG8_STAGE(PG8_SB(0, 1), cB + hstepB, voffB); PG8_STAGE(PG8_SA(0, 1), cA + hstepA, voffA);
    if (wr == 1) PG8_BAR;
    PG8_WAIT_V(4); PG8_BAR;
    PG8_STAGE(PG8_SB(1, 0), cB + kstep, voffB); PG8_STAGE(PG8_SA(1, 0), cA + kstep, voffA); PG8_STAGE(PG8_SB(1, 1), cB + hstepB + kstep, voffB);
    PG8_WAIT_V(6); PG8_BAR;
    for (;;) {
        const bool has_next = S.next(ui + 1, nxt);
        const char* nA = has_next ? (const char*)g.A + (size_t)nxt.pm * tstepA : cA; const char* nB = has_next ? (const char*)g.Bt + (size_t)nxt.pn * tstepB : cB;
        for (int t = 0; t < nt; t += 2) {
            const bool last = (t == nt - 2);
            const char* a1 = cA + (size_t)(t + 1) * kstep;
            const char* a2 = last ? nA : cA + (size_t)(t + 2) * kstep; const char* b2 = last ? nB : cB + (size_t)(t + 2) * kstep;
            const char* a3 = a2 + kstep; const char* b3 = b2 + kstep;
            PG8_LDB(B0, 0, 0); PG8_SCHED; PG8_LDA(At, 0, 0); PG8_STAGE(PG8_SA(1, 1), a1 + hstepA, voffA);
            PG8_WAIT_L(8); PG8_BAR; PG8_WAIT_L(0); PG8_MMA(0, 0, At, B0); PG8_BAR; PG8_SCHED;
            PG8_LDB(B1, 0, 1); PG8_STAGE(PG8_SB(0, 0), b2, voffB);
            PG8_BAR; PG8_WAIT_L(0); PG8_MMA(0, 1, At, B1); PG8_BAR;
            PG8_LDA(At, 0, 1); PG8_STAGE(PG8_SA(0, 0), a2, voffA);
            PG8_BAR; PG8_WAIT_L(0); PG8_MMA(1, 0, At, B0); PG8_BAR; PG8_SCHED;
            PG8_STAGE(PG8_SB(0, 1), b2 + hstepB, voffB);
            PG8_WAIT_V(6); PG8_BAR; PG8_MMA(1, 1, At, B1); PG8_BAR;
            PG8_LDB(B0, 1, 0); PG8_SCHED; PG8_LDA(At, 1, 0); PG8_STAGE(PG8_SA(0, 1), a2 + hstepA, voffA);
            PG8_WAIT_L(8); PG8_BAR; PG8_WAIT_L(0); PG8_MMA(0, 0, At, B0); PG8_BAR; PG8_SCHED;
            PG8_LDB(B1, 1, 1); PG8_STAGE(PG8_SB(1, 0), b3, voffB);
            PG8_BAR; PG8_WAIT_L(0); PG8_MMA(0, 1, At, B1); PG8_BAR;
            PG8_LDA(At, 1, 1); PG8_STAGE(PG8_SA(1, 0), a3, voffA);
            PG8_BAR; PG8_WAIT_L(0); PG8_MMA(1, 0, At, B0); PG8_BAR; PG8_SCHED;
            PG8_STAGE(PG8_SB(1, 1), b3 + hstepB, voffB);
            PG8_WAIT_V(6); PG8_BAR; PG8_MMA(1, 1, At, B1); PG8_BAR;
        }
        E(acc, cur, wr, wc, fr, fq);
        if (!has_next) break;
#pragma unroll
        for (int a = 0; a < 2; ++a)
#pragma unroll
            for (int b = 0; b < 2; ++b)
#pragma unroll
                for (int m = 0; m < 4; ++m)
#pragma unroll
                    for (int n = 0; n < 2; ++n) acc[a][b][m][n] = (f32x4){0.f, 0.f, 0.f, 0.f};
        cur = nxt; cA = nA; cB = nB; ++ui;
    }
    PG8_WAIT_V(0);
    if (wr == 0) PG8_BAR;
    PG8_BAR;
#undef PG8_SA
#undef PG8_SB
#undef PG8_STAGE
#undef PG8_LDA
#undef PG8_LDB
#undef PG8_MMA
#undef PG8_WAIT_V
#undef PG8_WAIT_L
#undef PG8_BAR
#undef PG8_SCHED
}
}
using pg8::Unit;
typedef f32x4 Acc[2][2][4][2];

__device__ __forceinline__ void arrive_wait(unsigned* cnt, unsigned want) {
    asm volatile("s_waitcnt vmcnt(0)" ::: "memory");
    if ((threadIdx.x & 63) == 0) __hip_atomic_fetch_add(cnt, 1u, __ATOMIC_RELAXED, __HIP_MEMORY_SCOPE_AGENT);
    unsigned sp = 0;
    while (__hip_atomic_load(cnt, __ATOMIC_RELAXED, __HIP_MEMORY_SCOPE_AGENT) < want) { __builtin_amdgcn_s_sleep(1); if (++sp > (1u << 21)) break; }
    asm volatile("" ::: "memory");
}
__device__ __forceinline__ float ld_agent(const float* p) { return __hip_atomic_load(p, __ATOMIC_RELAXED, __HIP_MEMORY_SCOPE_AGENT); }

struct EpiIn {
    bf16_t *q, *k, *v, *uh; float* us; const float* rope; float* out;
    __device__ __forceinline__ void operator()(const Acc& acc, const Unit& u, int wr, int wc, int fr_, int fq_) const { int lz; asm volatile("v_mov_b32 %0, 0" : "=v"(lz)); const int lane_ = __builtin_amdgcn_mbcnt_hi(~0u, __builtin_amdgcn_mbcnt_lo(~0u, lz)); const int fr = lane_ & 15, fq = lane_ >> 4;
        const int pn = u.pn;
#pragma unroll
        for (int ai = 0; ai < 2; ++ai)
#pragma unroll
            for (int m = 0; m < 4; ++m) {
                const int r = u.pm * 256 + ai * 128 + wr * 64 + m * 16 + fr;
                const bool samp = r >= NPR;
                const int rs_ = r - NPR;
                const int pos = samp ? 2048 + (rs_ & 15) : (r & 8191);
                if (pn <= 2) {
#pragma unroll
                    for (int bj = 0; bj < 2; ++bj) {
                        if (pn == 2 && bj == 1) {
#pragma unroll
                            for (int n = 0; n < 2; ++n) {
                                const int cv = wc * 32 + n * 16 + fq * 4; const f32x4 val = acc[ai][1][m][n];
                                *(u32x2*)(v + (size_t)r * 128 + cv) = pk4(val);
                                if (!samp) { const int t = r & 8191, b = r >> 13; if (t >= 8064) st4(out + O_VP + ((size_t)(b * 128 + t - 8064)) * 128 + cv, val); }
                                else { const int b = rs_ >> 4, s = rs_ & 15; st4(out + O_VS + ((size_t)(b * 128 + 112 + s)) * 128 + cv, val); }
                            }
                        } else {
                            const int wg = (pn == 2) ? wc : (bj * 4 + wc);
                            const int hl = wg >> 1, dbase = 16 * (wg & 1) + 4 * fq;
                            const f32x4 cs = ld4(rope + pos * 32 + dbase), sn = ld4(rope + 262144 + pos * 32 + dbase);
                            const f32x4 x1 = acc[ai][bj][m][0], x2 = acc[ai][bj][m][1];
                            const f32x4 o1 = x1 * cs - x2 * sn, o2 = x2 * cs + x1 * sn;
                            if (pn < 2) { bf16_t* dst = q + (size_t)r * 512 + (pn * 4 + hl) * 64 + dbase; *(u32x2*)dst = pk4(o1); *(u32x2*)(dst + 32) = pk4(o2); }
                            else {
                                const int cc = hl * 64 + dbase; bf16_t* dst = k + (size_t)r * 128 + cc; *(u32x2*)dst = pk4(o1); *(u32x2*)(dst + 32) = pk4(o2);
                                if (!samp) { const int t = r & 8191, b = r >> 13; if (t >= 8064) { float* o = out + O_KP + ((size_t)(b * 128 + t - 8064)) * 128 + cc; st4(o, o1); st4(o + 32, o2); } }
                                else { const int b = rs_ >> 4, s = rs_ & 15; float* o = out + O_KS + ((size_t)(b * 128 + 112 + s)) * 128 + cc; st4(o, o1); st4(o + 32, o2); }
                            }
                        }
                    }
                } else {
#pragma unroll
                    for (int bj = 0; bj < 2; ++bj)
#pragma unroll
                        for (int n = 0; n < 2; ++n) {
                            const int cu = 256 * (pn - 3) + 128 * bj + 32 * wc + 16 * n + 4 * fq; const int g = cu >> 4, c = cu & 15;
                            if (!samp) *(u32x2*)(uh + ((size_t)(g * 2048 + (r >> 4))) * 384 + (r & 15) * 16 + c) = pk4(acc[ai][bj][m][n]);
                            else st4(us + (size_t)rs_ * 512 + cu, acc[ai][bj][m][n]);
                        }
                }
            }
    }
};
struct EpiS {
    bf16_t* sb;
    __device__ __forceinline__ void operator()(const Acc& acc, const Unit& u, int wr, int wc, int fr_, int fq_) const { int lz; asm volatile("v_mov_b32 %0, 0" : "=v"(lz)); const int lane_ = __builtin_amdgcn_mbcnt_hi(~0u, __builtin_amdgcn_mbcnt_lo(~0u, lz)); const int fr = lane_ & 15, fq = lane_ >> 4;
#pragma unroll
        for (int ai = 0; ai < 2; ++ai)
#pragma unroll
            for (int m = 0; m < 4; ++m) {
                const int R = u.pm * 256 + ai * 128 + wr * 64 + m * 16 + fr;
#pragma unroll
                for (int n = 0; n < 2; ++n) *(u32x2*)(sb + (size_t)R * 128 + wc * 32 + n * 16 + fq * 4) = pk4(acc[ai][0][m][n]);
            }
    }
};
struct EpiY {
    bf16_t* z;
    __device__ __forceinline__ void operator()(const Acc& acc, const Unit& u, int wr, int wc, int fr_, int fq_) const {
        int lz; asm volatile("v_mov_b32 %0, 0" : "=v"(lz)); const int lane_ = __builtin_amdgcn_mbcnt_hi(~0u, __builtin_amdgcn_mbcnt_lo(~0u, lz)); const int fr = lane_ & 15, fq = lane_ >> 4;
#pragma unroll
        for (int ai = 0; ai < 2; ++ai)
#pragma unroll
            for (int m = 0; m < 4; ++m) {
                const int R = u.pm * 256 + ai * 128 + wr * 64 + m * 16 + fr; const int chunk = R & 2047, g = R >> 11;
#pragma unroll
                for (int bj = 0; bj < 2; ++bj) {
                    const int t = 8 * bj + 2 * wc + (fq >> 1); f32x4 y0 = acc[ai][bj][m][0], y1 = acc[ai][bj][m][1];
#pragma unroll
                    for (int i = 0; i < 4; ++i) { y0[i] = gelu_tanh(y0[i]); y1[i] = gelu_tanh(y1[i]); }
                    const u32x2 p0 = pk4(y0), p1 = pk4(y1); u32x4 w; w.x = p0.x; w.y = p0.y; w.z = p1.x; w.w = p1.y;
                    *(u32x4*)(z + ((size_t)(chunk * 16 + t)) * 512 + g * 16 + 8 * (fq & 1)) = w;
                }
            }
    }
};
struct EpiGlu {
    const bf16_t* z; bf16_t* mrg; float* rss; unsigned* cnt;
    __device__ __forceinline__ void operator()(Acc& acc, const Unit& u, int wr, int wc, int fr_, int fq_) const {
        int lz; asm volatile("v_mov_b32 %0, 0" : "=v"(lz)); const int lane_ = __builtin_amdgcn_mbcnt_hi(~0u, __builtin_amdgcn_mbcnt_lo(~0u, lz)); const int fr = lane_ & 15, fq = lane_ >> 4;
#pragma unroll
        for (int ai = 0; ai < 2; ++ai)
#pragma unroll
            for (int m = 0; m < 4; ++m) {
                const int r = u.pm * 256 + ai * 128 + wr * 64 + m * 16 + fr;
#pragma unroll
                for (int bj = 0; bj < 2; ++bj) {
                    const int col = u.pn * 256 + bj * 128 + wc * 32 + fq * 8;
                    const u32x4 zw = *(const u32x4*)(z + (size_t)r * 512 + col); const f32x4 a0 = acc[ai][bj][m][0], a1 = acc[ai][bj][m][1];
                    f32x4 o0, o1; o0[0] = bflo(zw.x) * sigmoidf(a0[0]); o0[1] = bfhi(zw.x) * sigmoidf(a0[1]); o0[2] = bflo(zw.y) * sigmoidf(a0[2]); o0[3] = bfhi(zw.y) * sigmoidf(a0[3]);
                    o1[0] = bflo(zw.z) * sigmoidf(a1[0]); o1[1] = bfhi(zw.z) * sigmoidf(a1[1]); o1[2] = bflo(zw.w) * sigmoidf(a1[2]); o1[3] = bfhi(zw.w) * sigmoidf(a1[3]);
                    acc[ai][bj][m][0] = o0; acc[ai][bj][m][1] = o1;
                }
                if (m == 3) __builtin_amdgcn_sched_barrier(0);
            }
#pragma unroll
        for (int ai = 0; ai < 2; ++ai)
#pragma unroll
            for (int m = 0; m < 4; ++m) {
                const int r = u.pm * 256 + ai * 128 + wr * 64 + m * 16 + fr; float ssq = 0.f;
#pragma unroll
                for (int bj = 0; bj < 2; ++bj)
#pragma unroll
                    for (int n = 0; n < 2; ++n) { const f32x4 o = acc[ai][bj][m][n]; ssq += (o[0] * o[0] + o[1] * o[1]) + (o[2] * o[2] + o[3] * o[3]); }
                ssq += __shfl_xor(ssq, 16); ssq += __shfl_xor(ssq, 32);
                if (fq == 0) atomicAdd(rss + r, ssq);
            }
        arrive_wait(cnt + (256 + u.pm * 2 + wr) * 16, 8u);
        float rsv[2][4];
#pragma unroll
        for (int ai = 0; ai < 2; ++ai)
#pragma unroll
            for (int m = 0; m < 4; ++m) rsv[ai][m] = ld_agent(rss + u.pm * 256 + ai * 128 + wr * 64 + m * 16 + fr);
#pragma unroll
        for (int ai = 0; ai < 2; ++ai)
#pragma unroll
            for (int m = 0; m < 4; ++m) {
                const int r = u.pm * 256 + ai * 128 + wr * 64 + m * 16 + fr;
                const float rstd = rsqrtf(rsv[ai][m] * (1.0f / 512.0f) + EPS);
#pragma unroll
                for (int bj = 0; bj < 2; ++bj) {
                    const int col = u.pn * 256 + bj * 128 + wc * 32 + fq * 8;
                    const u32x2 p0 = pk4(acc[ai][bj][m][0] * rstd), p1 = pk4(acc[ai][bj][m][1] * rstd); u32x4 w; w.x = p0.x; w.y = p0.y; w.z = p1.x; w.w = p1.y;
                    *(u32x4*)(mrg + (size_t)r * 1024 + 512 + col) = w;
                }
            }
    }
};
struct EpiOut {
    const float* xp; const float* xs; bf16_t* x1b; float* rss; unsigned* cnt;
    __device__ __forceinline__ void operator()(Acc& acc, const Unit& u, int wr, int wc, int fr_, int fq_) const {
        int lz; asm volatile("v_mov_b32 %0, 0" : "=v"(lz)); const int lane_ = __builtin_amdgcn_mbcnt_hi(~0u, __builtin_amdgcn_mbcnt_lo(~0u, lz)); const int fr = lane_ & 15, fq = lane_ >> 4;
#pragma unroll
        for (int ai = 0; ai < 2; ++ai)
#pragma unroll
            for (int m = 0; m < 4; ++m) {
                const int r = u.pm * 256 + ai * 128 + wr * 64 + m * 16 + fr; float ssq = 0.f;
                const float* xr = xp + (size_t)r * 1024;
#pragma unroll
                for (int bj = 0; bj < 2; ++bj)
#pragma unroll
                    for (int n = 0; n < 2; ++n) {
                        const int col = u.pn * 256 + bj * 128 + wc * 32 + fq * 8 + n * 4;
                        const f32x4 o = ld4(xr + col) + acc[ai][bj][m][n];
                        ssq += (o[0] * o[0] + o[1] * o[1]) + (o[2] * o[2] + o[3] * o[3]);
                        acc[ai][bj][m][n] = o;
                    }
                ssq += __shfl_xor(ssq, 16); ssq += __shfl_xor(ssq, 32);
                if (fq == 0) atomicAdd(rss + r, ssq);
            }
        arrive_wait(cnt + (528 + u.pm * 2 + wr) * 16, 16u);
        float rsv[2][4];
#pragma unroll
        for (int ai = 0; ai < 2; ++ai)
#pragma unroll
            for (int m = 0; m < 4; ++m) rsv[ai][m] = ld_agent(rss + u.pm * 256 + ai * 128 + wr * 64 + m * 16 + fr);
#pragma unroll
        for (int ai = 0; ai < 2; ++ai)
#pragma unroll
            for (int m = 0; m < 4; ++m) {
                const int r = u.pm * 256 + ai * 128 + wr * 64 + m * 16 + fr;
                const float rstd = rsqrtf(rsv[ai][m] * (1.0f / 1024.0f) + EPS);
#pragma unroll
                for (int bj = 0; bj < 2; ++bj) {
                    const int col = u.pn * 256 + bj * 128 + wc * 32 + fq * 8;
                    const u32x2 p0 = pk4(acc[ai][bj][m][0] * rstd), p1 = pk4(acc[ai][bj][m][1] * rstd); u32x4 w; w.x = p0.x; w.y = p0.y; w.z = p1.x; w.w = p1.y;
                    *(u32x4*)(x1b + (size_t)r * 1024 + col) = w;
                }
            }
    }
};
struct EpiUp {
    const float* cw; const float* cb; bf16_t* hb; float* eb;
    __device__ __forceinline__ void operator()(const Acc& acc, const Unit& u, int wr, int wc, int fr_, int fq_) const {
        int lz; asm volatile("v_mov_b32 %0, 0" : "=v"(lz));
        const int lane = __builtin_amdgcn_mbcnt_hi(~0u, __builtin_amdgcn_mbcnt_lo(~0u, lz));
        const int fr = lane & 15, fq = lane >> 4;
#define DPPR1(v) __int_as_float(__builtin_amdgcn_update_dpp(0, __float_as_int(v), 0x121, 0xF, 0xF, true))
        const int cbase = u.pn * 128 + wc * 32 + fq * 8;
        f32x4 wg[2][4], wv[2][4];
#pragma unroll
        for (int n = 0; n < 2; ++n) {
            const int cg = cbase + n * 4, cv = DFF + cg;
            wg[n][0] = ld4(cw + cg); wg[n][1] = ld4(cw + DFF2 + cg); wg[n][2] = ld4(cw + 2 * DFF2 + cg); wg[n][3] = ld4(cb + cg);
            wv[n][0] = ld4(cw + cv); wv[n][1] = ld4(cw + DFF2 + cv); wv[n][2] = ld4(cw + 2 * DFF2 + cv); wv[n][3] = ld4(cb + cv);
        }
#pragma unroll
        for (int ai = 0; ai < 2; ++ai)
#pragma unroll
            for (int bj = 0; bj < 2; ++bj)
#pragma unroll
                for (int n = 0; n < 2; ++n) {
                    const int jblk = u.pm * 4 + ai * 2 + wr; const int col = bj * DFF + cbase + n * 4;
                    if (fr == 0) { st4(eb + ((size_t)jblk * 4 + 0) * DFF2 + col, acc[ai][bj][0][n]); st4(eb + ((size_t)jblk * 4 + 1) * DFF2 + col, acc[ai][bj][1][n]); }
                    if (fr == 15) { st4(eb + ((size_t)jblk * 4 + 2) * DFF2 + col, acc[ai][bj][2][n]); st4(eb + ((size_t)jblk * 4 + 3) * DFF2 + col, acc[ai][bj][3][n]); }
                }
        __builtin_amdgcn_sched_barrier(0);
#pragma unroll
        for (int ai = 0; ai < 2; ++ai) {
            const int r0 = u.pm * 256 + ai * 128 + wr * 64 + 4 * fr;
            u32x2 pk[2][4];
#pragma unroll
            for (int n = 0; n < 2; ++n) {
                const f32x4 w0g = wg[n][0], w1g = wg[n][1], w2g = wg[n][2], bg = wg[n][3], w0v = wv[n][0], w1v = wv[n][1], w2v = wv[n][2], bv = wv[n][3];
                const f32x4 g0 = acc[ai][0][0][n], g1 = acc[ai][0][1][n], g2 = acc[ai][0][2][n], g3 = acc[ai][0][3][n];
                const f32x4 v0 = acc[ai][1][0][n], v1 = acc[ai][1][1][n], v2 = acc[ai][1][2][n], v3 = acc[ai][1][3][n];
                f32x4 qg2, qg3, qv2, qv3;
#pragma unroll
                for (int i = 0; i < 4; ++i) { qg2[i] = DPPR1(g2[i]); qg3[i] = DPPR1(g3[i]); qv2[i] = DPPR1(v2[i]); qv3[i] = DPPR1(v3[i]); }
                const f32x4 cg0 = w2g * g0 + w1g * qg3 + w0g * qg2 + bg, cv0 = w2v * v0 + w1v * qv3 + w0v * qv2 + bv;
                const f32x4 cg1 = w2g * g1 + w1g * g0 + w0g * qg3 + bg, cv1 = w2v * v1 + w1v * v0 + w0v * qv3 + bv;
                const f32x4 cg2 = w2g * g2 + w1g * g1 + w0g * g0 + bg, cv2 = w2v * v2 + w1v * v1 + w0v * v0 + bv;
                const f32x4 cg3 = w2g * g3 + w1g * g2 + w0g * g1 + bg, cv3 = w2v * v3 + w1v * v2 + w0v * v1 + bv;
                f32x4 h0, h1, h2, h3;
#pragma unroll
                for (int i = 0; i < 4; ++i) { h0[i] = cg0[i] * sigmoidf(cg0[i]) * cv0[i]; h1[i] = cg1[i] * sigmoidf(cg1[i]) * cv1[i]; h2[i] = cg2[i] * sigmoidf(cg2[i]) * cv2[i]; h3[i] = cg3[i] * sigmoidf(cg3[i]) * cv3[i]; }
                pk[n][0] = pk4(h0); pk[n][1] = pk4(h1); pk[n][2] = pk4(h2); pk[n][3] = pk4(h3);
            }
            bf16_t* hp = hb + (size_t)r0 * DFF + cbase;
#pragma unroll
            for (int m = 0; m < 4; ++m) { u32x4 w; w.x = pk[0][m].x; w.y = pk[0][m].y; w.z = pk[1][m].x; w.w = pk[1][m].y; *(u32x4*)(hp + (size_t)m * DFF) = w; }
            __builtin_amdgcn_sched_barrier(0);
        }
#undef DPPR1
    }
};
struct EpiDown {
    const bf16_t* x1b; float* out; float* rss; unsigned* cnt; const float* fg; const float* rss2;
    __device__ __forceinline__ void operator()(Acc& acc, const Unit& u, int wr, int wc, int fr_, int fq_) const {
        int lz; asm volatile("v_mov_b32 %0, 0" : "=v"(lz)); const int lane_ = __builtin_amdgcn_mbcnt_hi(~0u, __builtin_amdgcn_mbcnt_lo(~0u, lz)); const int fr = lane_ & 15, fq = lane_ >> 4;
#pragma unroll
        for (int ai = 0; ai < 2; ++ai)
#pragma unroll
            for (int m = 0; m < 4; ++m) {
                const int r = u.pm * 256 + ai * 128 + wr * 64 + m * 16 + fr;
                const float inv2 = sqrtf(rss2[r] * (1.0f / 1024.0f) + EPS);
#pragma unroll
                for (int bj = 0; bj < 2; ++bj)
#pragma unroll
                    for (int n = 0; n < 2; ++n) {
                        const int col = u.pn * 256 + bj * 128 + wc * 32 + n * 16 + fq * 4;
                        const u32x2 xw = *(const u32x2*)(x1b + (size_t)r * 1024 + col); f32x4 o = acc[ai][bj][m][n];
                        o[0] += bflo(xw.x) * inv2; o[1] += bfhi(xw.x) * inv2; o[2] += bflo(xw.y) * inv2; o[3] += bfhi(xw.y) * inv2;
                        acc[ai][bj][m][n] = o;
                    }
                if (m == 3) __builtin_amdgcn_sched_barrier(0);
            }
#pragma unroll
        for (int ai = 0; ai < 2; ++ai)
#pragma unroll
            for (int m = 0; m < 4; ++m) {
                const int r = u.pm * 256 + ai * 128 + wr * 64 + m * 16 + fr; float ssq = 0.f;
#pragma unroll
                for (int bj = 0; bj < 2; ++bj)
#pragma unroll
                    for (int n = 0; n < 2; ++n) { const f32x4 o = acc[ai][bj][m][n]; ssq += (o[0] * o[0] + o[1] * o[1]) + (o[2] * o[2] + o[3] * o[3]); }
                ssq += __shfl_xor(ssq, 16); ssq += __shfl_xor(ssq, 32);
                if (fq == 0) atomicAdd(rss + r, ssq);
            }
        f32x4 gf[2][2];
#pragma unroll
        for (int bj = 0; bj < 2; ++bj)
#pragma unroll
            for (int n = 0; n < 2; ++n) gf[bj][n] = ld4(fg + u.pn * 256 + bj * 128 + wc * 32 + n * 16 + fq * 4);
        arrive_wait(cnt + (u.pm * 2 + wr) * 16, 16u);
        float rsv[2][4];
#pragma unroll
        for (int ai = 0; ai < 2; ++ai)
#pragma unroll
            for (int m = 0; m < 4; ++m) rsv[ai][m] = ld_agent(rss + u.pm * 256 + ai * 128 + wr * 64 + m * 16 + fr);
#pragma unroll
        for (int ai = 0; ai < 2; ++ai)
#pragma unroll
            for (int m = 0; m < 4; ++m) {
                const int r = u.pm * 256 + ai * 128 + wr * 64 + m * 16 + fr;
                const float rstd = rsqrtf(rsv[ai][m] * (1.0f / 1024.0f) + EPS);
#pragma unroll
                for (int bj = 0; bj < 2; ++bj)
#pragma unroll
                    for (int n = 0; n < 2; ++n) {
                        const int col = u.pn * 256 + bj * 128 + wc * 32 + n * 16 + fq * 4;
                        __builtin_nontemporal_store(acc[ai][bj][m][n] * rstd * gf[bj][n], (f32x4*)(out + (size_t)r * 1024 + col));
                    }
            }
    }
};

__device__ __forceinline__ int ropeperm(int nl) { return 16 * (nl >> 5) + 32 * ((nl >> 4) & 1) + (nl & 15); }
struct TrTile { const float* src; bf16_t* dst; const float* gain; int ldsrc, K, kt, srcc0, dstn0, perm; };
__device__ __forceinline__ TrTile p0_tile(const P& p, unsigned char* ws, int t) {
    TrTile T; T.gain = nullptr; T.perm = 0;
    if (t < 320) { const int kt = t / 20, gq = t % 20; T.src = p.w_in; T.ldsrc = 1280; T.dst = (bf16_t*)(ws + WS_WIN); T.K = 1024; T.kt = kt; T.srcc0 = gq * 64; T.dstn0 = gq * 64; T.perm = (gq < 10) ? 1 : 0; }
    else if (t < 384) { const int u = t - 320, kt = u / 8, gq = u % 8; T.src = p.w_glu; T.ldsrc = 512; T.dst = (bf16_t*)(ws + WS_WGLU); T.K = 512; T.kt = kt; T.srcc0 = gq * 64; T.dstn0 = gq * 64; }
    else if (t < 640) { const int u = t - 384, kt = u / 16, gq = u % 16; T.src = p.w_out; T.ldsrc = 1024; T.dst = (bf16_t*)(ws + WS_WOUT); T.K = 1024; T.kt = kt; T.srcc0 = gq * 64; T.dstn0 = gq * 64; if (kt >= 8) T.gain = p.on_s - 512; }
    else if (t < 2048) { const int u = t - 640, kt = u / 88, gq = u % 88; const int pn = gq >> 2, q4 = gq & 3;
        T.src = p.w_up; T.ldsrc = DFF2; T.dst = (bf16_t*)(ws + WS_WUP); T.K = 1024; T.kt = kt; T.srcc0 = (q4 < 2) ? pn * 128 + q4 * 64 : DFF + pn * 128 + (q4 - 2) * 64; T.dstn0 = gq * 64; T.gain = p.norm2_g; }
    else { const int u = t - 2048, kt = u / 16, gq = u % 16; T.src = p.w_down; T.ldsrc = 1024; T.dst = (bf16_t*)(ws + WS_WDOWN); T.K = DFF; T.kt = kt; T.srcc0 = gq * 64; T.dstn0 = gq * 64; }
    return T;
}
__device__ __forceinline__ void p0_tr_load(const TrTile& T, f32x4 (&v)[2]) {
    const int tid = threadIdx.x;
#pragma unroll
    for (int i = 0; i < 2; ++i) { const int idx = tid + i * NTHR; const int kr = idx >> 4, c4 = (idx & 15) * 4;
        v[i] = ld4(T.src + (size_t)(T.kt * 64 + kr) * T.ldsrc + T.srcc0 + c4);
        if (T.gain) v[i] *= T.gain[T.kt * 64 + kr]; }
}
__device__ __forceinline__ void p0_tr_store(LAS float* tile, const TrTile& T, const f32x4 (&v)[2]) {
    const int tid = threadIdx.x;
#pragma unroll
    for (int i = 0; i < 2; ++i) { const int idx = tid + i * NTHR; const int kr = idx >> 4, c4 = (idx & 15) * 4;
        tile[kr * 65 + c4 + 0] = v[i][0]; tile[kr * 65 + c4 + 1] = v[i][1]; tile[kr * 65 + c4 + 2] = v[i][2]; tile[kr * 65 + c4 + 3] = v[i][3]; }
    __syncthreads();
    const int nl = tid >> 3, ks = (tid & 7) * 8; const int sl = T.perm ? ropeperm(nl) : nl;
    u32x4 w;
    w.x = pk2(tile[(ks + 0) * 65 + sl], tile[(ks + 1) * 65 + sl]); w.y = pk2(tile[(ks + 2) * 65 + sl], tile[(ks + 3) * 65 + sl]);
    w.z = pk2(tile[(ks + 4) * 65 + sl], tile[(ks + 5) * 65 + sl]); w.w = pk2(tile[(ks + 6) * 65 + sl], tile[(ks + 7) * 65 + sl]);
    *(u32x4*)(T.dst + (size_t)(T.dstn0 + nl) * T.K + T.kt * 64 + ks) = w;
    __syncthreads();
}

__device__ __forceinline__ void p0_tr_range(LAS unsigned char* lds, const P& p, int t0, int stride, int t1) {
    LAS float* tile = (LAS float*)lds; unsigned char* ws = p.ws;
    int t = t0;
    if (t < t1) {
        TrTile T = p0_tile(p, ws, t); f32x4 v[2]; p0_tr_load(T, v);
        for (;;) {
            const int tn = t + stride; const bool more = tn < t1;
            TrTile Tn = T; f32x4 vn[2] = {v[0], v[1]};
            if (more) { Tn = p0_tile(p, ws, tn); p0_tr_load(Tn, vn); }
            p0_tr_store(tile, T, v);
            if (!more) break;
            T = Tn; v[0] = vn[0]; v[1] = vn[1]; t = tn;
        }
    }
}

__device__ __forceinline__ void phase0(LAS unsigned char* lds, const P& p) {
    unsigned char* ws = p.ws;
    const int tid = threadIdx.x, lane = tid & 63, wave = tid >> 6;
    const int G = gridDim.x, blk = blockIdx.x;
    const size_t gtid = (size_t)blk * NTHR + tid, gstride = (size_t)G * NTHR;
    { float* z = (float*)(ws + WS_RSS_S); const size_t n = (WS_ROPE - WS_RSS_S) / 4; for (size_t i = gtid; i < n; i += gstride) z[i] = 0.f; }
    { float* rope = (float*)(ws + WS_ROPE);
      for (size_t i = gtid; i < 8192 * 32; i += gstride) { const int pos = (int)(i >> 5), f = (int)(i & 31);
          const float inv = powf(10000.0f, -(float)f / 32.0f); const float ang = (float)pos * inv; float s, c; sincosf(ang, &s, &c); rope[i] = c; rope[262144 + i] = s; } }
    { for (size_t i = gtid; i < (size_t)16 * 112 * 128; i += gstride) { const size_t b = i / (112 * 128), rem = i % (112 * 128);
          p.out[O_KS + b * 16384 + rem] = p.cache_k[b * 16384 + 2048 + rem]; p.out[O_VS + b * 16384 + rem] = p.cache_v[b * 16384 + 2048 + rem]; } }
    p0_tr_range(lds, p, blk, G, 320);
    { bf16_t* xn = (bf16_t*)(ws + WS_XN1);
      const int nsk = (G > 2 * NG) ? NG : 0;
      if (blk >= nsk) for (int r4 = ((blk - nsk) * 8 + wave) * 4; r4 < MR; r4 += (G - nsk) * 32) {
          f32x4 v[4][4]; float ss[4];
#pragma unroll
          for (int q = 0; q < 4; ++q) { const int r = r4 + q; const float* xr = (r < NPR) ? p.x_prompt + (size_t)r * 1024 : p.x_sample + (size_t)(r - NPR) * 1024;
#pragma unroll
              for (int i = 0; i < 4; ++i) v[q][i] = ld4(xr + i * 256 + lane * 4); }
#pragma unroll
          for (int q = 0; q < 4; ++q) { float a = 0.f;
#pragma unroll
              for (int i = 0; i < 4; ++i) a += (v[q][i][0] * v[q][i][0] + v[q][i][1] * v[q][i][1]) + (v[q][i][2] * v[q][i][2] + v[q][i][3] * v[q][i][3]);
              ss[q] = rsqrtf(wsum(a) * (1.0f / 1024.0f) + EPS); }
#pragma unroll
          for (int i = 0; i < 4; ++i) { const f32x4 g = ld4(p.norm1_g + i * 256 + lane * 4);
#pragma unroll
              for (int q = 0; q < 4; ++q) *(u32x2*)(xn + (size_t)(r4 + q) * 1024 + i * 256 + lane * 4) = pk4(v[q][i] * ss[q] * g); }
      } }
    __syncthreads();
    for (int g = blk; g < NG; g += G) {
        LAS float* lamre = (LAS float*)lds;
        LAS float* lamim = lamre + 17 * 64;
        LAS float* coef = lamim + 17 * 64;
        LAS float* bbre = coef + 128;
        LAS float* bbim = bbre + 1024;
        LAS float* cre = bbim + 1024;
        LAS float* cim = cre + 1024;
        LAS float* km = cim + 1024;
        float* lamT = (float*)(ws + WS_LAM); float* bbar = (float*)(ws + WS_BBAR);
        if (tid < 64) {
            const int pp = tid; const float dt = expf(p.log_dt[g]); const float ar = p.A_re[g * 64 + pp], ai = p.A_im[g * 64 + pp];
            for (int k = 0; k <= 16; ++k) { const float mag = expf((float)k * dt * ar); float s, c; sincosf((float)k * dt * ai, &s, &c); lamre[k * 64 + pp] = mag * c; lamim[k * 64 + pp] = mag * s; }
            const float lr = lamre[64 + pp] - 1.0f, li = lamim[64 + pp], den = ar * ar + ai * ai;
            coef[pp] = (lr * ar + li * ai) / den; coef[64 + pp] = (li * ar - lr * ai) / den;
            float* lt = lamT + (size_t)(g * 64 + pp) * 4; lt[0] = lamre[64 + pp]; lt[1] = lamim[64 + pp]; lt[2] = lamre[16 * 64 + pp]; lt[3] = lamim[16 * 64 + pp];
        }
        __syncthreads();
        for (int e = tid; e < 1024; e += NTHR) {
            const int pp = e >> 4; const float br = p.B_re[g * 1024 + e], bi = p.B_im[g * 1024 + e], cr = coef[pp], ci = coef[64 + pp];
            const float vr = cr * br - ci * bi, vi = cr * bi + ci * br; bbre[e] = vr; bbim[e] = vi;
            bbar[((size_t)g * 1024 + e) * 2] = vr; bbar[((size_t)g * 1024 + e) * 2 + 1] = vi;
            cre[e] = p.C_re[g * 1024 + e]; cim[e] = p.C_im[g * 1024 + e];
        }
        __syncthreads();
        for (int e = tid; e < 4096; e += NTHR) {
            const int tau = e >> 8, co = (e >> 4) & 15, ci = e & 15; float sum = 0.f;
            for (int pp = 0; pp < 64; ++pp) { const float c_r = cre[co * 64 + pp], c_i = cim[co * 64 + pp], l_r = lamre[tau * 64 + pp], l_i = lamim[tau * 64 + pp];
                const float clr = c_r * l_r - c_i * l_i, cli = c_r * l_i + c_i * l_r; sum += clr * bbre[pp * 16 + ci] - cli * bbim[pp * 16 + ci]; }
            if (tau == 0 && co == ci) sum += p.Dskip[g * 16 + co];
            km[e] = sum;
        }
        __syncthreads();
        bf16_t* wy = (bf16_t*)(ws + WS_WY) + (size_t)g * 256 * 384;
        for (int v = tid; v < 256 * 48; v += NTHR) {
            const int n = v / 48, k0 = (v % 48) * 8; const int t = n >> 4, co = n & 15; float f[8];
            if (k0 < 256) { const int s = k0 >> 4, ci0 = k0 & 15;
#pragma unroll
                for (int j = 0; j < 8; ++j) f[j] = (s <= t) ? km[((t - s) << 8) + (co << 4) + ci0 + j] : 0.f;
            } else { const int j0 = k0 - 256;
#pragma unroll
                for (int j = 0; j < 8; ++j) { const int jj = j0 + j, pp = jj & 63; const float c_r = cre[co * 64 + pp], c_i = cim[co * 64 + pp], l_r = lamre[(t + 1) * 64 + pp], l_i = lamim[(t + 1) * 64 + pp];
                    f[j] = (jj < 64) ? (c_r * l_r - c_i * l_i) : -(c_r * l_i + c_i * l_r); }
            }
            u32x4 w; w.x = pk2(f[0], f[1]); w.y = pk2(f[2], f[3]); w.z = pk2(f[4], f[5]); w.w = pk2(f[6], f[7]);
            *(u32x4*)(wy + (size_t)n * 384 + k0) = w;
        }
        bf16_t* wsm = (bf16_t*)(ws + WS_WS) + (size_t)g * 256 * 256;
        for (int v = tid; v < 256 * 32; v += NTHR) {
            const int n = v >> 5, k0 = (v & 31) * 8; float f[8];
            if (n < 128) { const int pp = n & 63, s = k0 >> 4, c0 = k0 & 15; const float l_r = lamre[(15 - s) * 64 + pp], l_i = lamim[(15 - s) * 64 + pp];
#pragma unroll
                for (int j = 0; j < 8; ++j) { const float b_r = bbre[pp * 16 + c0 + j], b_i = bbim[pp * 16 + c0 + j]; f[j] = (n < 64) ? (l_r * b_r - l_i * b_i) : (l_r * b_i + l_i * b_r); }
            } else {
#pragma unroll
                for (int j = 0; j < 8; ++j) f[j] = 0.f;
            }
            u32x4 w; w.x = pk2(f[0], f[1]); w.y = pk2(f[2], f[3]); w.z = pk2(f[4], f[5]); w.w = pk2(f[6], f[7]);
            *(u32x4*)(wsm + (size_t)n * 256 + k0) = w;
        }
        __syncthreads();
    }
}

__device__ __forceinline__ void attn_qblock(const bf16x8 Bq0, const bf16x8 Bq1, const LAS bf16_t* Ksh, const LAS bf16_t* Vth, LAS float* ssrow, int kb0, int padblk, int fr, int fq, float sink,
                                            f32x4& o0, f32x4& o1, f32x4& o2, f32x4& o3) {
    bf16x8 Bq[2] = {Bq0, Bq1};
    f32x4 S[12];
#pragma unroll
    for (int kbk = 0; kbk < 12; ++kbk) {
        S[kbk] = (f32x4){0.f, 0.f, 0.f, 0.f};
        if (kbk >= kb0) {
#pragma unroll
            for (int kk = 0; kk < 2; ++kk) { const bf16x8 a = *(const LAS bf16x8*)(Ksh + (kbk * 16 + fr) * 72 + kk * 32 + fq * 8); S[kbk] = __builtin_amdgcn_mfma_f32_16x16x32_bf16(a, Bq[kk], S[kbk], 0, 0, 0); }
            if (kbk == padblk) S[kbk] = (f32x4){-3.0e38f, -3.0e38f, -3.0e38f, -3.0e38f};
        }
    }
    float mx = -3.0e38f;
#pragma unroll
    for (int kbk = 0; kbk < 12; ++kbk) if (kbk >= kb0) mx = fmaxf(mx, fmaxf(fmaxf(S[kbk][0], S[kbk][1]), fmaxf(S[kbk][2], S[kbk][3])));
    mx = fmaxf(mx, __shfl_xor(mx, 16)); mx = fmaxf(mx, __shfl_xor(mx, 32));
    const float mm = fmaxf(mx * 0.125f, sink); float sum = 0.f;
#pragma unroll
    for (int kbk = 0; kbk < 12; ++kbk) {
        if (kbk >= kb0) {
#pragma unroll
            for (int j = 0; j < 4; ++j) { const float e = __expf(S[kbk][j] * 0.125f - mm); S[kbk][j] = e; sum += e; }
        }
    }
    sum += __shfl_xor(sum, 16); sum += __shfl_xor(sum, 32);
    const float inv = 1.0f / (sum + __expf(sink - mm));
    f32x4 Ot[4];
#pragma unroll
    for (int db = 0; db < 4; ++db) Ot[db] = (f32x4){0.f, 0.f, 0.f, 0.f};
#pragma unroll
    for (int ks = 0; ks < 6; ++ks) {
        if (2 * ks >= kb0) {
            u32x4 pw; pw.x = pk2(S[2 * ks][0] * inv, S[2 * ks][1] * inv); pw.y = pk2(S[2 * ks][2] * inv, S[2 * ks][3] * inv);
            pw.z = pk2(S[2 * ks + 1][0] * inv, S[2 * ks + 1][1] * inv); pw.w = pk2(S[2 * ks + 1][2] * inv, S[2 * ks + 1][3] * inv);
            const bf16x8 pb = __builtin_bit_cast(bf16x8, pw);
#pragma unroll
            for (int db = 0; db < 4; ++db) {
                const LAS bf16_t* vp = Vth + (db * 16 + fr) * 200 + ks * 32 + fq * 4;
                const u32x2 lo = *(const LAS u32x2*)vp, hi = *(const LAS u32x2*)(vp + 16);
                u32x4 aw; aw.x = lo.x; aw.y = lo.y; aw.z = hi.x; aw.w = hi.y;
                Ot[db] = __builtin_amdgcn_mfma_f32_16x16x32_bf16(__builtin_bit_cast(bf16x8, aw), pb, Ot[db], 0, 0, 0);
            }
        }
    }
    float ssq = 0.f;
#pragma unroll
    for (int db = 0; db < 4; ++db) ssq += (Ot[db][0] * Ot[db][0] + Ot[db][1] * Ot[db][1]) + (Ot[db][2] * Ot[db][2] + Ot[db][3] * Ot[db][3]);
    ssq += __shfl_xor(ssq, 16); ssq += __shfl_xor(ssq, 32);
    if (fq == 0) *ssrow = ssq;
    o0 = Ot[0]; o1 = Ot[1]; o2 = Ot[2]; o3 = Ot[3];
}
__device__ __forceinline__ void attn_qstore(bf16_t* mrow, const LAS float* ssrow, const float* ga, int fq, const f32x4& o0, const f32x4& o1, const f32x4& o2, const f32x4& o3) {
    float tot = 0.f;
#pragma unroll
    for (int hh = 0; hh < 8; ++hh) tot += ssrow[hh];
    const float rstd = rsqrtf(tot * (1.0f / 512.0f) + EPS);
    *(u32x2*)(mrow + 0 * 16 + fq * 4) = pk4(o0 * rstd * ld4(ga + 0 * 16 + fq * 4));
    *(u32x2*)(mrow + 1 * 16 + fq * 4) = pk4(o1 * rstd * ld4(ga + 1 * 16 + fq * 4));
    *(u32x2*)(mrow + 2 * 16 + fq * 4) = pk4(o2 * rstd * ld4(ga + 2 * 16 + fq * 4));
    *(u32x2*)(mrow + 3 * 16 + fq * 4) = pk4(o3 * rstd * ld4(ga + 3 * 16 + fq * 4));
}

__device__ __forceinline__ void attn_prompt_item(LAS unsigned char* lds, const P& p, int item) {
    const unsigned char* ws = p.ws;
    const bf16_t* qb = (const bf16_t*)(ws + WS_Q); const bf16_t* kb = (const bf16_t*)(ws + WS_K); const bf16_t* vb = (const bf16_t*)(ws + WS_V);
    bf16_t* mrg = (bf16_t*)(p.ws + WS_MRG);
    const int tid = threadIdx.x, lane = tid & 63, h = __builtin_amdgcn_readfirstlane(tid >> 6), fr = lane & 15, fq = lane >> 4;
    const int b = item >> 7, n = item & 127;
    const int r0 = b * 8192 + n * 64;
    const int kb0 = n >= 2 ? 0 : (n == 1 ? 4 : 8);
    const int key0tok = r0 - 128;
    bf16x8 Q0a, Q0b, Q1a, Q1b, Q2a, Q2b, Q3a, Q3b;
    { const bf16_t* qrow0 = qb + (size_t)(r0 + fr) * 512 + h * 64 + fq * 8;
      Q0a = *(const bf16x8*)(qrow0); Q0b = *(const bf16x8*)(qrow0 + 32); Q1a = *(const bf16x8*)(qrow0 + 16 * 512); Q1b = *(const bf16x8*)(qrow0 + 16 * 512 + 32);
      Q2a = *(const bf16x8*)(qrow0 + 32 * 512); Q2b = *(const bf16x8*)(qrow0 + 32 * 512 + 32); Q3a = *(const bf16x8*)(qrow0 + 48 * 512); Q3b = *(const bf16x8*)(qrow0 + 48 * 512 + 32); }
    LAS bf16_t* Ks = (LAS bf16_t*)lds;
    LAS bf16_t* Vt = (LAS bf16_t*)(lds + 55296);
    LAS float* ss = (LAS float*)(lds + 55296 + 51200);
#pragma unroll
    for (int i = 0; i < 6; ++i) {
        const int idx = tid + i * NTHR; const int key = idx >> 4, pc = idx & 15;
        if (key >= kb0 * 16) { const u32x4 w = *(const u32x4*)(kb + (size_t)(key0tok + key) * 128 + pc * 8); *(LAS u32x4*)(Ks + ((pc >> 3) * 192 + key) * 72 + (pc & 7) * 8) = w; }
    }
#pragma unroll
    for (int i = 0; i < 6; ++i) {
        const int idx = tid + i * NTHR; const int key = idx % 192, pc = idx / 192;
        if (key >= kb0 * 16) {
            const u32x4 w = *(const u32x4*)(vb + (size_t)(key0tok + key) * 128 + pc * 8);
            LAS bf16_t* d = Vt + ((pc >> 3) * 64 + (pc & 7) * 8) * 200 + key;
            d[0] = (bf16_t)(w.x & 0xffff); d[200] = (bf16_t)(w.x >> 16); d[400] = (bf16_t)(w.y & 0xffff); d[600] = (bf16_t)(w.y >> 16);
            d[800] = (bf16_t)(w.z & 0xffff); d[1000] = (bf16_t)(w.z >> 16); d[1200] = (bf16_t)(w.w & 0xffff); d[1400] = (bf16_t)(w.w >> 16);
        }
    }
    __syncthreads();
    const int kvh = h >> 2;
    const float sink = p.sinks[h];
    const LAS bf16_t* Ksh = Ks + kvh * 192 * 72; const LAS bf16_t* Vth = Vt + kvh * 64 * 200;
    f32x4 a0, a1, a2, a3, b0, b1, b2, b3, c0, c1, c2, c3, d0, d1, d2, d3;
    attn_qblock(Q0a, Q0b, Ksh, Vth, ss + (0 * 16 + fr) * 8 + h, kb0, -1, fr, fq, sink, a0, a1, a2, a3);
    attn_qblock(Q1a, Q1b, Ksh, Vth, ss + (1 * 16 + fr) * 8 + h, kb0, -1, fr, fq, sink, b0, b1, b2, b3);
    attn_qblock(Q2a, Q2b, Ksh, Vth, ss + (2 * 16 + fr) * 8 + h, kb0, -1, fr, fq, sink, c0, c1, c2, c3);
    attn_qblock(Q3a, Q3b, Ksh, Vth, ss + (3 * 16 + fr) * 8 + h, kb0, -1, fr, fq, sink, d0, d1, d2, d3);
    __syncthreads();
    bf16_t* mrow = mrg + (size_t)(r0 + fr) * 1024 + h * 64; const float* ga = p.on_a + h * 64;
    attn_qstore(mrow, ss + (0 * 16 + fr) * 8, ga, fq, a0, a1, a2, a3);
    attn_qstore(mrow + 16 * 1024, ss + (1 * 16 + fr) * 8, ga, fq, b0, b1, b2, b3);
    attn_qstore(mrow + 32 * 1024, ss + (2 * 16 + fr) * 8, ga, fq, c0, c1, c2, c3);
    attn_qstore(mrow + 48 * 1024, ss + (3 * 16 + fr) * 8, ga, fq, d0, d1, d2, d3);
    __syncthreads();
}

__device__ __forceinline__ void attn_sample_item(LAS unsigned char* lds, const P& p, int b) {
    const unsigned char* ws = p.ws;
    const bf16_t* qb = (const bf16_t*)(ws + WS_Q); const bf16_t* kb = (const bf16_t*)(ws + WS_K); const bf16_t* vb = (const bf16_t*)(ws + WS_V);
    bf16_t* mrg = (bf16_t*)(p.ws + WS_MRG);
    const int tid = threadIdx.x, lane = tid & 63, h = __builtin_amdgcn_readfirstlane(tid >> 6), fr = lane & 15, fq = lane >> 4;
    const int r0 = NPR + b * 16;
    const bf16_t* qrow0 = qb + (size_t)(r0 + fr) * 512 + h * 64 + fq * 8;
    const bf16x8 Qa = *(const bf16x8*)(qrow0), Qb = *(const bf16x8*)(qrow0 + 32);
    LAS bf16_t* Ks = (LAS bf16_t*)lds;
    LAS bf16_t* Vt = (LAS bf16_t*)(lds + 55296);
    LAS float* ss = (LAS float*)(lds + 55296 + 51200);
#pragma unroll
    for (int i = 0; i < 4; ++i) {
        const int idx = tid + i * NTHR; const int key = idx >> 4, pc = idx & 15; const int kvh = pc >> 3, d0 = (pc & 7) * 8;
        const float* src = p.cache_k + ((size_t)(b * 128 + key) * 2 + kvh) * 64 + d0; const f32x4 x0 = ld4(src), x1 = ld4(src + 4);
        u32x4 w; w.x = pk2(x0[0], x0[1]); w.y = pk2(x0[2], x0[3]); w.z = pk2(x1[0], x1[1]); w.w = pk2(x1[2], x1[3]);
        *(LAS u32x4*)(Ks + (kvh * 192 + 48 + key) * 72 + d0) = w;
    }
    { const int t2 = tid & 255; const int key = t2 >> 4, pc = t2 & 15; const int kvh = pc >> 3, d0 = (pc & 7) * 8;
      u32x4 w = (u32x4){0u, 0u, 0u, 0u};
      if (tid < 256) w = *(const u32x4*)(kb + (size_t)(r0 + key) * 128 + pc * 8);
      *(LAS u32x4*)(Ks + (kvh * 192 + (tid < 256 ? 176 : 32) + key) * 72 + d0) = w; }
#pragma unroll
    for (int i = 0; i < 4; ++i) {
        const int idx = tid + i * NTHR; const int key = idx & 127, pc = idx >> 7; const int kvh = pc >> 3, d0 = (pc & 7) * 8;
        const float* src = p.cache_v + ((size_t)(b * 128 + key) * 2 + kvh) * 64 + d0; const f32x4 x0 = ld4(src), x1 = ld4(src + 4);
        const unsigned w0 = pk2(x0[0], x0[1]), w1 = pk2(x0[2], x0[3]), w2 = pk2(x1[0], x1[1]), w3 = pk2(x1[2], x1[3]);
        LAS bf16_t* d = Vt + (kvh * 64 + d0) * 200 + 48 + key;
        d[0] = (bf16_t)(w0 & 0xffff); d[200] = (bf16_t)(w0 >> 16); d[400] = (bf16_t)(w1 & 0xffff); d[600] = (bf16_t)(w1 >> 16);
        d[800] = (bf16_t)(w2 & 0xffff); d[1000] = (bf16_t)(w2 >> 16); d[1200] = (bf16_t)(w3 & 0xffff); d[1400] = (bf16_t)(w3 >> 16);
    }
    { const int t2 = tid & 255; const int key = t2 & 15, pc = t2 >> 4; const int kvh = pc >> 3, d0 = (pc & 7) * 8;
      u32x4 w = (u32x4){0u, 0u, 0u, 0u};
      if (tid < 256) w = *(const u32x4*)(vb + (size_t)(r0 + key) * 128 + pc * 8);
      LAS bf16_t* d = Vt + (kvh * 64 + d0) * 200 + (tid < 256 ? 176 : 32) + key;
      d[0] = (bf16_t)(w.x & 0xffff); d[200] = (bf16_t)(w.x >> 16); d[400] = (bf16_t)(w.y & 0xffff); d[600] = (bf16_t)(w.y >> 16);
      d[800] = (bf16_t)(w.z & 0xffff); d[1000] = (bf16_t)(w.z >> 16); d[1200] = (bf16_t)(w.w & 0xffff); d[1400] = (bf16_t)(w.w >> 16); }
    __syncthreads();
    const int kvh = h >> 2; const float sink = p.sinks[h];
    f32x4 a0, a1, a2, a3;
    attn_qblock(Qa, Qb, Ks + kvh * 192 * 72, Vt + kvh * 64 * 200, ss + fr * 8 + h, 2, 2, fr, fq, sink, a0, a1, a2, a3);
    __syncthreads();
    attn_qstore(mrg + (size_t)(r0 + fr) * 1024 + h * 64, ss + fr * 8, p.on_a + h * 64, fq, a0, a1, a2, a3);
    __syncthreads();
}

__device__ __forceinline__ void ssm_sample_task(const P& p, int task) {
    const unsigned char* ws = p.ws;
    const float* lamT = (const float*)(ws + WS_LAM); const float* bbar = (const float*)(ws + WS_BBAR); const float* us = (const float*)(ws + WS_US);
    bf16_t* z = (bf16_t*)(p.ws + WS_Z);
    const int lane = threadIdx.x & 63, b = task >> 7, g = (task >> 2) & 31, qd = task & 3, pp = lane;
    const float lr = lamT[(size_t)(g * 64 + pp) * 4], li = lamT[(size_t)(g * 64 + pp) * 4 + 1];
    float bbr[16], bbi[16], cr[4], ci[4];
#pragma unroll
    for (int c = 0; c < 16; ++c) { bbr[c] = bbar[((size_t)(g * 64 + pp) * 16 + c) * 2]; bbi[c] = bbar[((size_t)(g * 64 + pp) * 16 + c) * 2 + 1]; }
#pragma unroll
    for (int c = 0; c < 4; ++c) { cr[c] = p.C_re[g * 1024 + (qd * 4 + c) * 64 + pp]; ci[c] = p.C_im[g * 1024 + (qd * 4 + c) * 64 + pp]; }
    float hr = p.st_re[(size_t)(b * 32 + g) * 64 + pp], hi = p.st_im[(size_t)(b * 32 + g) * 64 + pp];
    const float dsk = (lane < 4) ? p.Dskip[g * 16 + qd * 4 + lane] : 0.f;
    for (int t = 0; t < 16; ++t) {
        const float* ur = us + (size_t)(b * 16 + t) * 512 + g * 16;
        const float ul = (lane < 16) ? ur[lane] : 0.f;
        float bur = 0.f, bui = 0.f;
#pragma unroll
        for (int c = 0; c < 16; ++c) { const float uc = __shfl(ul, c); bur += bbr[c] * uc; bui += bbi[c] * uc; }
        const float nr = lr * hr - li * hi + bur, ni = lr * hi + li * hr + bui; hr = nr; hi = ni;
        float yv = 0.f;
#pragma unroll
        for (int c = 0; c < 4; ++c) { const float v = wsum(cr[c] * hr - ci[c] * hi); yv = (lane == c) ? v : yv; }
        const float zz = gelu_tanh(yv + dsk * __shfl(ul, qd * 4 + (lane & 3)));
        const float zn = __shfl_down(zz, 1);
        if (lane < 4 && (lane & 1) == 0) *(unsigned*)(z + (size_t)(NPR + b * 16 + t) * 512 + g * 16 + qd * 4 + lane) = pk2(zz, zn);
    }
    if (qd == 0) { p.out[O_RS + (size_t)(b * 32 + g) * 64 + pp] = hr; p.out[O_IS + (size_t)(b * 32 + g) * 64 + pp] = hi; }
}

__device__ __forceinline__ void scan_task(LAS unsigned char* lds, const P& p, int task) {
    const float* __restrict__ lamT = (const float*)(p.ws + WS_LAM); const bf16_t* __restrict__ sb = (const bf16_t*)(p.ws + WS_SB);
    bf16_t* __restrict__ uh = (bf16_t*)(p.ws + WS_UH);
    LAS float* ex = (LAS float*)lds;
    const int lane = threadIdx.x & 63, seg = threadIdx.x >> 6, b = task >> 5, g = task & 31, pp = lane;
    const float lr = lamT[(size_t)(g * 64 + pp) * 4 + 2], li = lamT[(size_t)(g * 64 + pp) * 4 + 3];
    const size_t R0 = (size_t)g * 2048 + (size_t)b * 512 + (size_t)seg * 64;
    float er = 0.f, ei = 0.f;
    for (int c0 = 0; c0 < 64; c0 += 16) {
        float sr[16], si[16];
#pragma unroll
        for (int j = 0; j < 16; ++j) { sr[j] = bf2f(sb[(R0 + c0 + j) * 128 + pp]); si[j] = bf2f(sb[(R0 + c0 + j) * 128 + 64 + pp]); }
#pragma unroll
        for (int j = 0; j < 16; ++j) { const float nr = lr * er - li * ei + sr[j], ni = lr * ei + li * er + si[j]; er = nr; ei = ni; }
    }
    ex[(seg * 64 + pp) * 2] = er; ex[(seg * 64 + pp) * 2 + 1] = ei;
    float qr = lr, qi = li;
#pragma unroll
    for (int k = 0; k < 6; ++k) { const float nr = qr * qr - qi * qi, ni = 2.0f * qr * qi; qr = nr; qi = ni; }
    __syncthreads();
    float hr = 0.f, hi = 0.f;
    for (int s2 = 0; s2 < seg; ++s2) { const float xr = ex[(s2 * 64 + pp) * 2], xi = ex[(s2 * 64 + pp) * 2 + 1]; const float nr = qr * hr - qi * hi + xr, ni = qr * hi + qi * hr + xi; hr = nr; hi = ni; }
    for (int c0 = 0; c0 < 64; c0 += 16) {
        float sr[16], si[16];
#pragma unroll
        for (int j = 0; j < 16; ++j) { sr[j] = bf2f(sb[(R0 + c0 + j) * 128 + pp]); si[j] = bf2f(sb[(R0 + c0 + j) * 128 + 64 + pp]); }
#pragma unroll
        for (int j = 0; j < 16; ++j) {
            uh[(R0 + c0 + j) * 384 + 256 + pp] = (bf16_t)(pk2(hr, 0.f) & 0xffff); uh[(R0 + c0 + j) * 384 + 320 + pp] = (bf16_t)(pk2(hi, 0.f) & 0xffff);
            const float nr = lr * hr - li * hi + sr[j], ni = lr * hi + li * hr + si[j]; hr = nr; hi = ni;
        }
    }
    if (seg == 7) { p.out[O_RP + (size_t)(b * 32 + g) * 64 + pp] = hr; p.out[O_IP + (size_t)(b * 32 + g) * 64 + pp] = hi; }
    __syncthreads();
}

__device__ __forceinline__ void sgemm_tile(const bf16_t* __restrict__ A, int lda, const bf16_t* __restrict__ W, int ldb, int K, int rb, int n0, int n1, int fr, int fq, f32x4& acc0, f32x4& acc1) {
    const bf16_t* ap = A + (size_t)(rb * 16 + fr) * lda + fq * 8;
    const bf16_t* b0p = W + (size_t)(n0 + fr) * ldb + fq * 8;
    const bf16_t* b1p = W + (size_t)(n1 + fr) * ldb + fq * 8;
    f32x4 c0 = (f32x4){0.f, 0.f, 0.f, 0.f}, c1 = (f32x4){0.f, 0.f, 0.f, 0.f};
    int k0 = 0;
    for (; k0 + 256 <= K; k0 += 256) {
        bf16x8 a[8], b0[8], b1[8];
#pragma unroll
        for (int j = 0; j < 8; ++j) { a[j] = *(const bf16x8*)(ap + k0 + j * 32); b0[j] = *(const bf16x8*)(b0p + k0 + j * 32); b1[j] = *(const bf16x8*)(b1p + k0 + j * 32); }
#pragma unroll
        for (int j = 0; j < 8; ++j) { c0 = __builtin_amdgcn_mfma_f32_16x16x32_bf16(b0[j], a[j], c0, 0, 0, 0); c1 = __builtin_amdgcn_mfma_f32_16x16x32_bf16(b1[j], a[j], c1, 0, 0, 0); }
    }
    for (; k0 + 64 <= K; k0 += 64) {
        bf16x8 a[2], b0[2], b1[2];
#pragma unroll
        for (int j = 0; j < 2; ++j) { a[j] = *(const bf16x8*)(ap + k0 + j * 32); b0[j] = *(const bf16x8*)(b0p + k0 + j * 32); b1[j] = *(const bf16x8*)(b1p + k0 + j * 32); }
#pragma unroll
        for (int j = 0; j < 2; ++j) { c0 = __builtin_amdgcn_mfma_f32_16x16x32_bf16(b0[j], a[j], c0, 0, 0, 0); c1 = __builtin_amdgcn_mfma_f32_16x16x32_bf16(b1[j], a[j], c1, 0, 0, 0); }
    }
    acc0 = c0; acc1 = c1;
}
template <int SPLIT>
__device__ __forceinline__ bool sgemm_tile_ks(LAS float* red, const bf16_t* __restrict__ A, int lda, const bf16_t* __restrict__ W, int ldb, int K, int rb, int n0, int n1, int fr, int fq, int wave, bool valid, f32x4& acc0, f32x4& acc1) {
    const int kq = wave % SPLIT, Kq = K / SPLIT, lane = fq * 16 + fr;
    f32x4 c0 = (f32x4){0.f, 0.f, 0.f, 0.f}, c1 = c0;
    if (valid) sgemm_tile(A + kq * Kq, lda, W + kq * Kq, ldb, Kq, rb, n0, n1, fr, fq, c0, c1);
    if (kq != 0) { *(LAS f32x4*)(red + (wave * 64 + lane) * 8) = c0; *(LAS f32x4*)(red + (wave * 64 + lane) * 8 + 4) = c1; }
    __syncthreads();
    if (kq == 0) {
#pragma unroll
        for (int s2 = 1; s2 < SPLIT; ++s2) { c0 += *(const LAS f32x4*)(red + ((wave + s2) * 64 + lane) * 8); c1 += *(const LAS f32x4*)(red + ((wave + s2) * 64 + lane) * 8 + 4); }
    }
    __syncthreads();
    acc0 = c0; acc1 = c1;
    return kq == 0 && valid;
}

__device__ __forceinline__ void sample_in(LAS unsigned char* lds, const P& p) {
    unsigned char* ws = p.ws;
    const int lane = threadIdx.x & 63, wave = threadIdx.x >> 6, fr = lane & 15, fq = lane >> 4, G = gridDim.x;
    const bf16_t* A = (const bf16_t*)(ws + WS_XN1) + (size_t)NPR * 1024; const bf16_t* W = (const bf16_t*)(ws + WS_WIN);
    bf16_t* q = (bf16_t*)(ws + WS_Q); bf16_t* k = (bf16_t*)(ws + WS_K); bf16_t* v = (bf16_t*)(ws + WS_V); float* us = (float*)(ws + WS_US); const float* rope = (const float*)(ws + WS_ROPE);
    for (int it = blockIdx.x; it < 320; it += G) {
        const int t = it * 2 + (wave >> 2); const int rb = t / 40, ct = t % 40; f32x4 x1, x2;
        if (!sgemm_tile_ks<4>((LAS float*)lds, A, 1024, W, 1024, 1024, rb, ct * 32, ct * 32 + 16, fr, fq, wave, true, x1, x2)) continue;
        const int rs_ = rb * 16 + fr, r = NPR + rs_, b = rb, sq = fr;
        if (ct < 20) {
            const int pos = 2048 + sq, dbase = 16 * (ct & 1) + 4 * fq;
            const f32x4 cs = ld4(rope + pos * 32 + dbase), sn = ld4(rope + 262144 + pos * 32 + dbase);
            const f32x4 o1 = x1 * cs - x2 * sn, o2 = x2 * cs + x1 * sn;
            if (ct < 16) { bf16_t* dst = q + (size_t)r * 512 + (ct >> 1) * 64 + dbase; *(u32x2*)dst = pk4(o1); *(u32x2*)(dst + 32) = pk4(o2); }
            else { const int cc = ((ct - 16) >> 1) * 64 + dbase; bf16_t* dst = k + (size_t)r * 128 + cc; *(u32x2*)dst = pk4(o1); *(u32x2*)(dst + 32) = pk4(o2);
                float* o = p.out + O_KS + ((size_t)(b * 128 + 112 + sq)) * 128 + cc; st4(o, o1); st4(o + 32, o2); }
        } else if (ct < 24) {
            const int cv = 32 * (ct - 20) + 4 * fq;
            *(u32x2*)(v + (size_t)r * 128 + cv) = pk4(x1); *(u32x2*)(v + (size_t)r * 128 + cv + 16) = pk4(x2);
            float* o = p.out + O_VS + ((size_t)(b * 128 + 112 + sq)) * 128 + cv; st4(o, x1); st4(o + 16, x2);
        } else {
            const int cu = 32 * (ct - 24) + 4 * fq; st4(us + (size_t)rs_ * 512 + cu, x1); st4(us + (size_t)rs_ * 512 + cu + 16, x2);
        }
    }
}
__device__ __forceinline__ void sample_glu(LAS unsigned char* lds, const P& p) {
    unsigned char* ws = p.ws;
    const int lane = threadIdx.x & 63, wave = threadIdx.x >> 6, fr = lane & 15, fq = lane >> 4, G = gridDim.x;
    const bf16_t* z = (const bf16_t*)(ws + WS_Z); bf16_t* mrg = (bf16_t*)(ws + WS_MRG); float* rss = (float*)(ws + WS_RSS_S);
    for (int it = blockIdx.x; it < 128; it += G) {
        const int t = it * 2 + (wave >> 2); const int rb = t >> 4, ct = t & 15; f32x4 a0, a1;
        if (!sgemm_tile_ks<4>((LAS float*)lds, z + (size_t)NPR * 512, 512, (const bf16_t*)(ws + WS_WGLU), 512, 512, rb, ct * 32, ct * 32 + 16, fr, fq, wave, true, a0, a1)) continue;
        const int r = NPR + rb * 16 + fr; float ssq = 0.f;
#pragma unroll
        for (int h = 0; h < 2; ++h) {
            const int col = ct * 32 + h * 16 + 4 * fq; const f32x4 a = h ? a1 : a0; const u32x2 zw = *(const u32x2*)(z + (size_t)r * 512 + col);
            f32x4 o; o[0] = bflo(zw.x) * sigmoidf(a[0]); o[1] = bfhi(zw.x) * sigmoidf(a[1]); o[2] = bflo(zw.y) * sigmoidf(a[2]); o[3] = bfhi(zw.y) * sigmoidf(a[3]);
            ssq += (o[0] * o[0] + o[1] * o[1]) + (o[2] * o[2] + o[3] * o[3]);
            *(u32x2*)(mrg + (size_t)r * 1024 + 512 + col) = pk4(o);
        }
        ssq += __shfl_xor(ssq, 16); ssq += __shfl_xor(ssq, 32);
        if (fq == 0) atomicAdd(rss + r, ssq);
    }
}
__device__ __forceinline__ void sample_out(LAS unsigned char* lds, const P& p) {
    unsigned char* ws = p.ws;
    const int lane = threadIdx.x & 63, wave = threadIdx.x >> 6, fr = lane & 15, fq = lane >> 4, G = gridDim.x;
    bf16_t* x1b = (bf16_t*)(ws + WS_X1B); float* rss = (float*)(ws + WS_RSS_2);
    for (int it = blockIdx.x; it < 256; it += G) {
        const int t = it * 2 + (wave >> 2); const int rb = t >> 5, ct = t & 31; f32x4 a0, a1, s0, s1;
        (void)sgemm_tile_ks<4>((LAS float*)lds, (const bf16_t*)(ws + WS_MRG) + (size_t)NPR * 1024, 1024, (const bf16_t*)(ws + WS_WOUT), 1024, 512, rb, ct * 32, ct * 32 + 16, fr, fq, wave, true, a0, a1);
        if (!sgemm_tile_ks<4>((LAS float*)lds, (const bf16_t*)(ws + WS_MRG) + (size_t)NPR * 1024 + 512, 1024, (const bf16_t*)(ws + WS_WOUT) + 512, 1024, 512, rb, ct * 32, ct * 32 + 16, fr, fq, wave, true, s0, s1)) continue;
        const int rs_ = rb * 16 + fr, r = NPR + rs_; float ssq = 0.f;
        { const float rstd_s = rsqrtf(((const float*)(ws + WS_RSS_S))[r] * (1.0f / 512.0f) + EPS); a0 += s0 * rstd_s; a1 += s1 * rstd_s; }
#pragma unroll
        for (int h = 0; h < 2; ++h) {
            const int col = ct * 32 + h * 16 + 4 * fq; const f32x4 o = ld4(p.x_sample + (size_t)rs_ * 1024 + col) + (h ? a1 : a0);
            ssq += (o[0] * o[0] + o[1] * o[1]) + (o[2] * o[2] + o[3] * o[3]);
            if (h) a1 = o; else a0 = o;
        }
        ssq += __shfl_xor(ssq, 16); ssq += __shfl_xor(ssq, 32);
        if (fq == 0) atomicAdd(rss + r, ssq);
        arrive_wait((unsigned*)(ws + WS_CNT) + (784 + rb) * 16, 32u);
        const float rstd = rsqrtf(ld_agent(rss + r) * (1.0f / 1024.0f) + EPS);
        { const int col = ct * 32 + 4 * fq; *(u32x2*)(x1b + (size_t)r * 1024 + col) = pk4(a0 * rstd); *(u32x2*)(x1b + (size_t)r * 1024 + col + 16) = pk4(a1 * rstd); }
    }
}
__device__ __forceinline__ void sample_up(LAS unsigned char* lds, const P& p) {
    unsigned char* ws = p.ws;
    const int lane = threadIdx.x & 63, wave = threadIdx.x >> 6, fr = lane & 15, fq = lane >> 4, G = gridDim.x;
    bf16_t* hb = (bf16_t*)(ws + WS_H); const float* rss2 = (const float*)(ws + WS_RSS_2); const float* cw = p.conv_w; const float* cb = p.conv_b; const float* sc = p.st_conv; float* ocs = p.out + O_CS;
#define DPPR(ctl, v) __int_as_float(__builtin_amdgcn_update_dpp(0, __float_as_int(v), (ctl), 0xF, 0xF, true))
    for (int it = blockIdx.x; it < 704; it += G) {
        const int t = it * 4 + (wave >> 1); const int rb = t / 176, ct = t % 176; const int pn = ct >> 3, j = ct & 7; f32x4 xg, xv;
        if (!sgemm_tile_ks<2>((LAS float*)lds, (const bf16_t*)(ws + WS_X1B) + (size_t)NPR * 1024, 1024, (const bf16_t*)(ws + WS_WUP), 1024, 1024, rb, pn * 256 + j * 16, pn * 256 + 128 + j * 16, fr, fq, wave, true, xg, xv)) continue;
        const int r = NPR + rb * 16 + fr, b = rb;
        const int cg = pn * 128 + j * 16 + 4 * fq, cv = DFF + cg;
        const f32x4 w0g = ld4(cw + cg), w1g = ld4(cw + DFF2 + cg), w2g = ld4(cw + 2 * DFF2 + cg), bg = ld4(cb + cg);
        const f32x4 w0v = ld4(cw + cv), w1v = ld4(cw + DFF2 + cv), w2v = ld4(cw + 2 * DFF2 + cv), bv = ld4(cb + cv);
        const f32x4 s0g = ld4(sc + (size_t)(b * 2) * DFF2 + cg), s1g = ld4(sc + (size_t)(b * 2 + 1) * DFF2 + cg);
        const f32x4 s0v = ld4(sc + (size_t)(b * 2) * DFF2 + cv), s1v = ld4(sc + (size_t)(b * 2 + 1) * DFF2 + cv);
        f32x4 hv;
#pragma unroll
        for (int i = 0; i < 4; ++i) {
            float p1g = DPPR(0x121, xg[i]), p2g = DPPR(0x122, xg[i]), p1v = DPPR(0x121, xv[i]), p2v = DPPR(0x122, xv[i]);
            p1g = fr == 0 ? s1g[i] : p1g; p2g = fr == 0 ? s0g[i] : (fr == 1 ? s1g[i] : p2g);
            p1v = fr == 0 ? s1v[i] : p1v; p2v = fr == 0 ? s0v[i] : (fr == 1 ? s1v[i] : p2v);
            const float gate = w0g[i] * p2g + w1g[i] * p1g + w2g[i] * xg[i] + bg[i], val = w0v[i] * p2v + w1v[i] * p1v + w2v[i] * xv[i] + bv[i];
            hv[i] = gate * sigmoidf(gate) * val;
        }
        *(u32x2*)(hb + (size_t)r * DFF + cg) = pk4(hv);
        if (fr >= 14) { float* e = ocs + ((size_t)b * 2 + (fr - 14)) * DFF2; st4(e + cg, xg); st4(e + cv, xv); }
    }
#undef DPPR
}
__device__ __forceinline__ void sample_down(LAS unsigned char* lds, const P& p) {
    unsigned char* ws = p.ws;
    const int lane = threadIdx.x & 63, wave = threadIdx.x >> 6, fr = lane & 15, fq = lane >> 4, G = gridDim.x;
    const bf16_t* x1b = (const bf16_t*)(ws + WS_X1B); float* rss = (float*)(ws + WS_RSS_3);
    for (int it = blockIdx.x; it < 256; it += G) {
        const int t = it * 2 + (wave >> 2); const int rb = t >> 5, ct = t & 31; f32x4 a0, a1;
        if (!sgemm_tile_ks<4>((LAS float*)lds, (const bf16_t*)(ws + WS_H) + (size_t)NPR * DFF, DFF, (const bf16_t*)(ws + WS_WDOWN), DFF, DFF, rb, ct * 32, ct * 32 + 16, fr, fq, wave, true, a0, a1)) continue;
        const int r = NPR + rb * 16 + fr; float ssq = 0.f;
#pragma unroll
        for (int h = 0; h < 2; ++h) {
            const int col = ct * 32 + h * 16 + 4 * fq; const u32x2 xw = *(const u32x2*)(x1b + (size_t)r * 1024 + col); f32x4 o = h ? a1 : a0;
            const float inv2 = sqrtf(((const float*)(ws + WS_RSS_2))[r] * (1.0f / 1024.0f) + EPS);
            o[0] += bflo(xw.x) * inv2; o[1] += bfhi(xw.x) * inv2; o[2] += bflo(xw.y) * inv2; o[3] += bfhi(xw.y) * inv2;
            ssq += (o[0] * o[0] + o[1] * o[1]) + (o[2] * o[2] + o[3] * o[3]);
            if (h) a1 = o; else a0 = o;
        }
        ssq += __shfl_xor(ssq, 16); ssq += __shfl_xor(ssq, 32);
        if (fq == 0) atomicAdd(rss + r, ssq);
        arrive_wait((unsigned*)(ws + WS_CNT) + (512 + rb) * 16, 32u);
        const float rstd = rsqrtf(ld_agent(rss + r) * (1.0f / 1024.0f) + EPS);
        { const int col = ct * 32 + 4 * fq; st4(p.out + (size_t)r * 1024 + col, a0 * rstd * ld4(p.final_g + col)); st4(p.out + (size_t)r * 1024 + col + 16, a1 * rstd * ld4(p.final_g + col + 16)); }
    }
}

__global__ void __launch_bounds__(NTHR) mega(P p) {
    extern __shared__ __attribute__((aligned(16))) unsigned char lds_raw[];
    LAS unsigned char* lds = (LAS unsigned char*)lds_raw;
    cg::grid_group grid = cg::this_grid();
    unsigned char* ws = p.ws;
    const int G = gridDim.x, blk = blockIdx.x, tid = threadIdx.x, lane = tid & 63, wave = tid >> 6;
    const int lo = p.ph_lo, hi = p.ph_hi;
#ifndef PHM
#define PHM 0xFFF
#endif
#define IN(k) (((PHM >> (k)) & 1) && lo <= (k) && (k) < hi)
    if (tid < 4) ((LAS unsigned*)(lds + 131072))[tid] = 0u;
    __syncthreads();
    (void)xcd_barrier_post((unsigned*)(ws + WS_BAR), (volatile LAS unsigned*)(lds + 131072));
#define SEAM(k) do { if (IN(k) && ((k) == 5 ? IN(7) : (k) == 8 ? IN(10) : IN((k) + 1))) { if (p.ph_lo < 0) grid.sync(); else { XcdBarrier xb_; xb_.bar = (unsigned*)(p.ws + WS_BAR); xb_.x = xb_xcc_id(); xb_.st = (volatile LAS unsigned*)(lds + 131072); xcd_barrier(xb_); } } } while (0)

    if (IN(0)) phase0(lds, p);
    SEAM(0);
    if (IN(1)) {
        pg8::Gemm g{(const bf16_t*)(ws + WS_XN1), (const bf16_t*)(ws + WS_WIN), 1024, 1024, 1024}; pg8::StaticOrder S; S.init(NPR, 1280, G, blk);
        sample_in(lds, p);
        EpiIn E{(bf16_t*)(ws + WS_Q), (bf16_t*)(ws + WS_K), (bf16_t*)(ws + WS_V), (bf16_t*)(ws + WS_UH), (float*)(ws + WS_US), (const float*)(ws + WS_ROPE), p.out};
        pg8::gemm_phase(lds, g, S, E);
        if (blk >= G / 2) { __syncthreads(); p0_tr_range(lds, p, 320 + (blk - G / 2), G - G / 2, 2048); }
    }
    SEAM(1);
    if (IN(2)) {
        { pg8::Gemm g{(const bf16_t*)(ws + WS_UH), (const bf16_t*)(ws + WS_WS), 384, 256, 256}; pg8::GroupOrder S{G, blk}; EpiS E{(bf16_t*)(ws + WS_SB)}; pg8::gemm_phase(lds, g, S, E); }
        __syncthreads();
        for (int task = blk * 8 + wave; task < 2048; task += 8 * G) ssm_sample_task(p, task);
        __syncthreads();
        for (int it0 = blk; it0 < 512; it0 += G) attn_prompt_item(lds, p, ((it0 & 7) << 6) | (it0 >> 3));
        for (int item = blk; item < 16; item += G) attn_sample_item(lds, p, item);
    }
    SEAM(2);
    if (IN(3)) { for (int task = blk; task < 128; task += G) scan_task(lds, p, task);
        if (blk >= G / 2) { __syncthreads(); p0_tr_range(lds, p, 2048 + (blk - G / 2), G - G / 2, 2752); } }
    SEAM(3);
    if (IN(4)) {
        pg8::Gemm g{(const bf16_t*)(ws + WS_UH), (const bf16_t*)(ws + WS_WY), 384, 384, 384}; pg8::GroupOrder S{G, blk}; EpiY E{(bf16_t*)(ws + WS_Z)}; pg8::gemm_phase<EpiY, pg8::GroupOrder, false, true>(lds, g, S, E);
    }
    SEAM(4);
    if (IN(5)) {
        pg8::Gemm g{(const bf16_t*)(ws + WS_Z), (const bf16_t*)(ws + WS_WGLU), 512, 512, 512}; pg8::StaticOrder S; S.init(NPR, 512, G, blk);
        sample_glu(lds, p);
        EpiGlu E{(const bf16_t*)(ws + WS_Z), (bf16_t*)(ws + WS_MRG), (float*)(ws + WS_RSS_S), (unsigned*)(ws + WS_CNT)}; pg8::gemm_phase<EpiGlu, pg8::StaticOrder, false, true>(lds, g, S, E);
    }
    SEAM(5);
    if (IN(7)) {
        pg8::Gemm g{(const bf16_t*)(ws + WS_MRG), (const bf16_t*)(ws + WS_WOUT), 1024, 1024, 1024}; pg8::StaticOrder S; S.init(NPR, 1024, G, blk);
        sample_out(lds, p);
        EpiOut E{p.x_prompt, p.x_sample, (bf16_t*)(ws + WS_X1B), (float*)(ws + WS_RSS_2), (unsigned*)(ws + WS_CNT)}; pg8::gemm_phase<EpiOut, pg8::StaticOrder, false, true>(lds, g, S, E);
    }
    SEAM(7);
    if (IN(8)) {
        pg8::Gemm g{(const bf16_t*)(ws + WS_X1B), (const bf16_t*)(ws + WS_WUP), 1024, 1024, 1024}; pg8::StaticOrder S; S.init(NPR, DFF2, G, blk);
        sample_up(lds, p);
        EpiUp E{p.conv_w, p.conv_b, (bf16_t*)(ws + WS_H), (float*)(ws + WS_EB)}; pg8::gemm_phase<EpiUp, pg8::StaticOrder, true, true>(lds, g, S, E);
    }
    SEAM(8);
    if (IN(10)) {
        pg8::Gemm g{(const bf16_t*)(ws + WS_H), (const bf16_t*)(ws + WS_WDOWN), DFF, DFF, DFF}; pg8::StaticOrder S; S.init(NPR, 1024, G, blk);
        sample_down(lds, p);
        {
            const float* eb = (const float*)(ws + WS_EB); bf16_t* hb = (bf16_t*)(ws + WS_H);
            pg8::Unit uu;
            for (int i = 0; S.next(i, uu); ++i) {
                for (int e = tid; e < 4 * DFF; e += NTHR) {
                    const int j = uu.pm * 4 + e / DFF, c = e % DFF;
                    const float* ee = eb + (size_t)j * 4 * DFF2;
                    const float e0g = ee[c], e0v = ee[DFF + c], e1g = ee[DFF2 + c], e1v = ee[DFF2 + DFF + c];
                    float p2g = 0.f, p2v = 0.f, p3g = 0.f, p3v = 0.f;
                    if (j & 127) { const float* q = ee - 2 * DFF2; p2g = q[c]; p2v = q[DFF + c]; p3g = q[DFF2 + c]; p3v = q[DFF2 + DFF + c]; }
                    const float w0g = p.conv_w[c], w1g = p.conv_w[DFF2 + c], w2g = p.conv_w[2 * DFF2 + c], bg = p.conv_b[c];
                    const float w0v = p.conv_w[DFF + c], w1v = p.conv_w[DFF2 + DFF + c], w2v = p.conv_w[2 * DFF2 + DFF + c], bv = p.conv_b[DFF + c];
                    const float g0 = w0g * p2g + w1g * p3g + w2g * e0g + bg, v0 = w0v * p2v + w1v * p3v + w2v * e0v + bv;
                    const float g1 = w0g * p3g + w1g * e0g + w2g * e1g + bg, v1 = w0v * p3v + w1v * e0v + w2v * e1v + bv;
                    hb[(size_t)(64 * j) * DFF + c] = (bf16_t)(pk2(g0 * sigmoidf(g0) * v0, 0.f) & 0xffff);
                    hb[(size_t)(64 * j + 1) * DFF + c] = (bf16_t)(pk2(g1 * sigmoidf(g1) * v1, 0.f) & 0xffff);
                }
            }
            for (size_t i = (size_t)blk * NTHR + tid; i < (size_t)4 * 2 * DFF2; i += (size_t)G * NTHR) {
                const int b = (int)(i / (2 * DFF2)), rem = (int)(i % (2 * DFF2)); const int sx = rem / DFF2, c = rem % DFF2;
                p.out[O_CP + i] = eb[((size_t)(128 * b + 127) * 4 + 2 + sx) * DFF2 + c];
            }
            asm volatile("s_waitcnt vmcnt(0)" ::: "memory");
            __syncthreads();
        }
        EpiDown E{(const bf16_t*)(ws + WS_X1B), p.out, (float*)(ws + WS_RSS_3), (unsigned*)(ws + WS_CNT), p.final_g, (const float*)(ws + WS_RSS_2)}; pg8::gemm_phase(lds, g, S, E);
    }
#undef IN
#undef SEAM
}

constexpr int NPHASE = 12;
#ifndef MK_PER_PHASE
#define MK_PER_PHASE 0
#endif

extern "C" void kernel_launch(void* const* d_in, const int* in_sizes, int n_in, void* d_out, int out_size, void* d_ws, size_t ws_size, hipStream_t stream) {
    static int grid = 0;
    if (grid == 0) {
        if (n_in != 28 || ws_size < WS_END) { fprintf(stderr, "kernel_launch: need 28 inputs and >= %zu bytes of workspace (got %d, %zu)\n", (size_t)WS_END, n_in, ws_size); grid = -1; return; }
        int dev = 0, cus = 0, per_cu = 0;
        hipGetDevice(&dev); hipDeviceGetAttribute(&cus, hipDeviceAttributeMultiprocessorCount, dev);
        if (hipFuncSetAttribute((const void*)mega, hipFuncAttributeMaxDynamicSharedMemorySize, LDS_BYTES) != hipSuccess) { fprintf(stderr, "kernel_launch: hipFuncSetAttribute failed\n"); grid = -1; return; }
        if (hipOccupancyMaxActiveBlocksPerMultiprocessor(&per_cu, (const void*)mega, NTHR, LDS_BYTES) != hipSuccess || per_cu < 1) { fprintf(stderr, "kernel_launch: occupancy query gave %d\n", per_cu); per_cu = 1; }
        (void)hipGetLastError();
        grid = cus * per_cu;
    }
    if (grid < 0) return;
    P p{};
    const float** pp = (const float**)&p;
    for (int i = 0; i < 28; ++i) pp[i] = (const float*)d_in[i];
    p.out = (float*)d_out; p.ws = (unsigned char*)d_ws;
#if MK_PER_PHASE
    for (int ph = 0; ph < NPHASE; ++ph) { p.ph_lo = ph; p.ph_hi = ph + 1; hipLaunchKernelGGL(mega, dim3(grid), dim3(NTHR), LDS_BYTES, stream, p); }
#else
    p.ph_lo = 0; p.ph_hi = NPHASE;
    if (hipMemsetAsync(d_ws, 0, (size_t)XCD_BAR_WORDS * 4, stream) != hipSuccess) { fprintf(stderr, "kernel_launch: memset of the barrier words failed\n"); return; }
    void* args[] = {&p};
    hipError_t e = hipLaunchCooperativeKernel((const void*)mega, dim3(grid), dim3(NTHR), args, LDS_BYTES, stream);
    if (e != hipSuccess) fprintf(stderr, "kernel_launch: cooperative launch failed: %s (grid %d)\n", hipGetErrorString(e), grid);
#endif
}
```
